# Optimizing an MI355X kernel written in HIP

```python
import math
import jax, jax.numpy as jnp
from jax import lax
import numpy as np

D_MODEL = 1024
BATCH = 16
SEQ = 2048
DEPTH = 2

N_MIXERS = 2
NORM_EPS = 1e-6

GLA_HEADS = 4
GLA_DK = D_MODEL // 2
GLA_DV = D_MODEL
GLA_DK_HEAD = GLA_DK // GLA_HEADS
GLA_DV_HEAD = GLA_DV // GLA_HEADS
GLA_RANK = 16
GLA_TAU = 16.0
GLA_CHUNK = 64
GLA_IN = 2 * GLA_DK + GLA_DV + GLA_RANK + GLA_DV

DSW_HEADS = 16
DSW_HEAD_DIM = D_MODEL // DSW_HEADS
DSW_WIDTH = DSW_HEADS * DSW_HEAD_DIM
DSW_GROUPS = ((128, 1), (512, 4), (2048, 16))
N_GROUPS = len(DSW_GROUPS)
DSW_IN = N_GROUPS * 3 * DSW_WIDTH + DSW_WIDTH

REL_BUCKETS = 32
REL_MAX_DIST = 2048

kernel_name = "hybrid_gla_dilated_swa_adaln"


def rmsnorm(x, g):
    x32 = x.astype(jnp.float32)
    y = x32 * lax.rsqrt(jnp.mean(x32 * x32, axis=-1, keepdims=True) + NORM_EPS)
    return y.astype(x.dtype) * g


def t5_causal_bucket(n):
    max_exact = REL_BUCKETS // 2
    nf = np.maximum(n, 1).astype(np.float32)
    large = max_exact + (np.log(nf / max_exact) / math.log(REL_MAX_DIST / max_exact)
                         * (REL_BUCKETS - max_exact)).astype(np.int32)
    large = np.minimum(large, REL_BUCKETS - 1)
    return np.where(n < max_exact, n, large).astype(np.int32)


def gla_mixer(h, w_in, w_alpha, b_alpha, norm_g, w_out):
    B, S, _ = h.shape
    H, dk, dv, C = GLA_HEADS, GLA_DK_HEAD, GLA_DV_HEAD, GLA_CHUNK
    nc = S // C
    proj = h @ w_in
    q, k, v, g_lr, r = jnp.split(
        proj, [GLA_DK, 2 * GLA_DK, 2 * GLA_DK + GLA_DV, 2 * GLA_DK + GLA_DV + GLA_RANK], axis=-1)
    log_a = jax.nn.log_sigmoid((g_lr @ w_alpha + b_alpha).astype(jnp.float32)) / GLA_TAU

    def chunks(t, d):
        return t.astype(jnp.float32).reshape(B, nc, C, H, d).transpose(0, 3, 1, 2, 4)

    q = chunks(q, dk) * (dk ** -0.5)
    k = chunks(k, dk)
    v = chunks(v, dv)
    b = jnp.cumsum(chunks(log_a, dk), axis=3)

    mid = b[:, :, :, C // 2:C // 2 + 1]
    a_intra = jnp.einsum('bhnid,bhnjd->bhnij', q * jnp.exp(b - mid), k * jnp.exp(mid - b))
    causal = jnp.tril(jnp.ones((C, C), dtype=bool))
    a_intra = jnp.where(causal, a_intra, 0.0)
    o = jnp.einsum('bhnij,bhnje->bhnie', a_intra, v)

    b_last = b[:, :, :, -1:]
    kv = jnp.einsum('bhnjd,bhnje->bhnde', k * jnp.exp(b_last - b), v)
    decay = jnp.exp(b_last[:, :, :, 0])

    def step(state, inp):
        dec, kv_n = inp
        return dec[..., None] * state + kv_n, state

    _, states = lax.scan(step, jnp.zeros((B, H, dk, dv), jnp.float32),
                         (decay.transpose(2, 0, 1, 3), kv.transpose(2, 0, 1, 3, 4)))
    o = o + jnp.einsum('bhnid,nbhde->bhnie', q * jnp.exp(b), states)

    o = o.transpose(0, 2, 3, 1, 4).reshape(B, S, H, dv)
    o = rmsnorm(o, norm_g)
    o = o.reshape(B, S, GLA_DV).astype(h.dtype) * jax.nn.silu(r)
    return o @ w_out


def dilated_group_attn(q, k, v, rel_bias, window, dil):
    B, S, H, Dh = q.shape
    span = window // dil
    L = S // dil
    nb = -(-L // span)
    Lp = nb * span

    def to_sub(t):
        t = t.reshape(B, L, dil, H, Dh).transpose(0, 2, 3, 1, 4)
        return jnp.pad(t, ((0, 0), (0, 0), (0, 0), (0, Lp - L), (0, 0)))

    def banded(t):
        tp = jnp.pad(to_sub(t), ((0, 0), (0, 0), (0, 0), (span, 0), (0, 0)))
        prev = tp[:, :, :, :Lp].reshape(B, dil, H, nb, span, Dh)
        cur = tp[:, :, :, span:].reshape(B, dil, H, nb, span, Dh)
        return jnp.concatenate([prev, cur], axis=-2)

    qs = to_sub(q).reshape(B, dil, H, nb, span, Dh)
    kb, vb = banded(k), banded(v)

    qi = np.arange(span)[:, None]
    kj = np.arange(2 * span)[None, :]
    steps = qi + span - kj
    in_window = (steps >= 0) & (steps <= span)
    bucket = t5_causal_bucket(np.clip(steps, 0, span) * dil)
    bias = rel_bias[bucket].transpose(2, 0, 1).astype(jnp.float32)
    first_block = (np.arange(nb) == 0)[:, None, None]
    mask = in_window[None] & (~first_block | (kj >= span)[None])

    logits = jnp.einsum('bdhnqe,bdhnke->bdhnqk', qs, kb).astype(jnp.float32) * (Dh ** -0.5)
    logits = jnp.where(mask, logits + bias[:, None], -jnp.inf)
    lse = jax.nn.logsumexp(logits, axis=-1)
    p = jnp.exp(logits - lse[..., None])
    o = jnp.einsum('bdhnqk,bdhnke->bdhnqe', p.astype(vb.dtype), vb)

    o = o.reshape(B, dil, H, Lp, Dh)[:, :, :, :L].transpose(0, 3, 1, 2, 4).reshape(B, S, H, Dh)
    lse = lse.reshape(B, dil, H, Lp)[:, :, :, :L].transpose(0, 3, 1, 2).reshape(B, S, H)
    return o, lse


def dilated_mixer(h, w_in, w_out, rel_bias):
    B, S, _ = h.shape
    proj = h @ w_in
    qkv = proj[..., :N_GROUPS * 3 * DSW_WIDTH].reshape(B, S, N_GROUPS, 3, DSW_HEADS, DSW_HEAD_DIM)
    gate = proj[..., N_GROUPS * 3 * DSW_WIDTH:]
    outs, lses = [], []
    for g, (window, dil) in enumerate(DSW_GROUPS):
        o, lse = dilated_group_attn(qkv[:, :, g, 0], qkv[:, :, g, 1], qkv[:, :, g, 2],
                                    rel_bias, window, dil)
        outs.append(o)
        lses.append(lse)
    w = jax.nn.softmax(jnp.stack(lses, axis=0), axis=0)
    o = jnp.sum(w[..., None] * jnp.stack(outs, axis=0).astype(jnp.float32), axis=0)
    o = o.reshape(B, S, DSW_WIDTH).astype(h.dtype) * jax.nn.silu(gate)
    return o @ w_out


def setup_inputs(seed: int = 0) -> dict:
    key = jax.random.key(seed)
    ks = jax.random.split(key, 16)
    n_gla = (DEPTH + N_MIXERS - 1) // N_MIXERS
    n_dsw = DEPTH // N_MIXERS
    nrm = jax.random.normal
    f32 = jnp.float32
    return {
        "x": nrm(ks[0], (BATCH, SEQ, D_MODEL), f32),
        "c": nrm(ks[1], (BATCH, D_MODEL), f32),
        "ada_w": nrm(ks[2], (DEPTH, D_MODEL, 3 * D_MODEL), f32) * D_MODEL ** -0.5,
        "ada_b": nrm(ks[3], (DEPTH, 3 * D_MODEL), f32) * 0.02,
        "norm_g": 1.0 + 0.05 * nrm(ks[4], (DEPTH, D_MODEL), f32),
        "gla_w_in": nrm(ks[5], (n_gla, D_MODEL, GLA_IN), f32) * D_MODEL ** -0.5,
        "gla_w_alpha": nrm(ks[6], (n_gla, GLA_RANK, GLA_DK), f32) * GLA_RANK ** -0.5,
        "gla_b_alpha": nrm(ks[7], (n_gla, GLA_DK), f32) * 0.1,
        "gla_norm_g": 1.0 + 0.05 * nrm(ks[8], (n_gla, GLA_DV_HEAD), f32),
        "gla_w_out": nrm(ks[9], (n_gla, GLA_DV, D_MODEL), f32) * GLA_DV ** -0.5,
        "dsw_w_in": nrm(ks[10], (n_dsw, D_MODEL, DSW_IN), f32) * D_MODEL ** -0.5,
        "dsw_w_out": nrm(ks[11], (n_dsw, DSW_WIDTH, D_MODEL), f32) * DSW_WIDTH ** -0.5,
        "rel_bias": nrm(ks[12], (REL_BUCKETS, DSW_HEADS), f32) * 0.5,
        "final_g": 1.0 + 0.05 * nrm(ks[13], (D_MODEL,), f32),
    }


def reference(x, c, ada_w, ada_b, norm_g, gla_w_in, gla_w_alpha, gla_b_alpha, gla_norm_g,
              gla_w_out, dsw_w_in, dsw_w_out, rel_bias, final_g):
    c_act = jax.nn.silu(c)
    for i in range(DEPTH):
        mod = c_act @ ada_w[i] + ada_b[i]
        shift, scale, gate = jnp.split(mod, 3, axis=-1)
        h = rmsnorm(x, norm_g[i]) * (1.0 + scale[:, None]) + shift[:, None]
        j = i // N_MIXERS
        if i % N_MIXERS == 0:
            y = gla_mixer(h, gla_w_in[j], gla_w_alpha[j], gla_b_alpha[j], gla_norm_g[j], gla_w_out[j])
        else:
            y = dilated_mixer(h, dsw_w_in[j], dsw_w_out[j], rel_bias)
        x = x + gate[:, None] * y
    return rmsnorm(x, final_g)
```

```cpp
#include <hip/hip_runtime.h>
#include <cstdio>
#include <cstdint>
namespace pg8 {
#define PG8_LAS __attribute__((address_space(3)))
typedef unsigned short bf16_t;
typedef short bf16x8 __attribute__((ext_vector_type(8)));
typedef float f32x4 __attribute__((ext_vector_type(4)));
typedef unsigned u32x4 __attribute__((ext_vector_type(4)));
constexpr int BM = 256, BK = 64, HALF = 128, HTB = HALF * BK * 2  , STAGE_BYTES = 8 * HTB, NXCD = 8, WGM = 8;

__host__ __device__ __forceinline__ int lds_byte(int r, int c) { const int st = (r >> 4) * 2 + (c >> 5), rr = r & 15, cc = c & 31, ob = rr * 64 + cc * 2; return st * 1024 + (ob ^ (((ob >> 9) & 1) << 5)); }
__host__ __device__ __forceinline__ void stage_rc(int b, int& R, int& C) { const int st = b / 1024, sb = b % 1024, swz = sb ^ (((sb >> 9) & 1) << 5); R = (st >> 1) * 16 + swz / 64; C = (st & 1) * 32 + (swz % 64) / 2; }
__host__ __device__ __forceinline__ int perm32(int rho) { const int n = rho >> 4, i = rho & 15; return 8 * (i >> 2) + 4 * n + (i & 3); }

struct Unit { int pm, pn; };
struct Gemm { const bf16_t* A; const bf16_t* Bt; int M, N, K; };

struct StaticOrder {
    int nM, nN, nwg, G, c;
    __host__ __device__ void init(int M, int N, int G_, int c_) { nM = M / BM; nN = N / BM; nwg = nM * nN; G = G_; c = c_; }
    __host__ __device__ bool next(int i, Unit& u) const {
        const long L = (long)i * G + c; if (L >= nwg) return false;
        int wgid = (int)L; { const int q = nwg / NXCD, r = nwg % NXCD, xcd = wgid % NXCD, off = wgid / NXCD; wgid = (xcd < r ? xcd * (q + 1) : r * (q + 1) + (xcd - r) * q) + off; }
        const int nig = WGM * nN, gid = wgid / nig, fm = gid * WGM, gsz = (nM - fm) < WGM ? (nM - fm) : WGM;
        u.pm = fm + ((wgid % nig) % gsz); u.pn = (wgid % nig) / gsz; return true;
    }
    __device__ __forceinline__ void a_ready(const Unit&) const {}
    __device__ __forceinline__ void done(const Unit&) const {}
};

__device__ __forceinline__ unsigned cvt_pk_bf16(float lo, float hi) { unsigned r; asm volatile("v_cvt_pk_bf16_f32 %0, %1, %2" : "=v"(r) : "v"(lo), "v"(hi)); return r; }

struct EpiBf16S {
    static constexpr bool PERM = true, AFTER_DRAIN = false;
    bf16_t* O; int ldc; int nscale; float scale0;
    __device__ __forceinline__ void operator()(const f32x4 (&acc)[2][2][4][2], const Unit& u, int wr, int wc, int fr, int fq) const {
        const int row0 = u.pm * BM + wr * 64 + fr, col0 = u.pn * BM + wc * 32 + 8 * fq;
        const float sc = (u.pn < nscale) ? scale0 : 1.f;
#pragma unroll
        for (int ai = 0; ai < 2; ++ai)
#pragma unroll
            for (int m = 0; m < 4; ++m) { bf16_t* rowp = O + (size_t)(row0 + ai * HALF + m * 16) * ldc + col0;
#pragma unroll
                for (int bj = 0; bj < 2; ++bj) { const f32x4 v0 = acc[ai][bj][m][0] * sc, v1 = acc[ai][bj][m][1] * sc;
                    u32x4 w; w.x = cvt_pk_bf16(v0[0], v0[1]); w.y = cvt_pk_bf16(v0[2], v0[3]); w.z = cvt_pk_bf16(v1[0], v1[1]); w.w = cvt_pk_bf16(v1[2], v1[3]);
                    *(u32x4*)(rowp + bj * HALF) = w; } }
    }
};
struct EpiQkvGate {
    static constexpr bool PERM = true, AFTER_DRAIN = false;
    bf16_t* QKV; bf16_t* G; float qscale;
    __device__ __forceinline__ void operator()(const f32x4 (&acc)[2][2][4][2], const Unit& u, int wr, int wc, int fr, int fq) const {
        const int row0 = u.pm * BM + wr * 64 + fr;
        const bool isg = u.pn >= 36;
        const int ldc = isg ? 1024 : 9216;
        const int col0 = (isg ? (u.pn - 36) : u.pn) * BM + wc * 32 + 8 * fq;
        bf16_t* base = isg ? G : QKV;
        const float sc = (!isg && (u.pn % 12) < 4) ? qscale : 1.f;
#pragma unroll
        for (int ai = 0; ai < 2; ++ai)
#pragma unroll
            for (int m = 0; m < 4; ++m) { bf16_t* rowp = base + (size_t)(row0 + ai * HALF + m * 16) * ldc + col0;
#pragma unroll
                for (int bj = 0; bj < 2; ++bj) { f32x4 v0 = acc[ai][bj][m][0] * sc, v1 = acc[ai][bj][m][1] * sc;
                    if (isg) {
#pragma unroll
                        for (int e = 0; e < 4; ++e) { v0[e] = v0[e] * __builtin_amdgcn_rcpf(1.f + __builtin_amdgcn_exp2f(-1.4426950408889634f * v0[e]));
                                                      v1[e] = v1[e] * __builtin_amdgcn_rcpf(1.f + __builtin_amdgcn_exp2f(-1.4426950408889634f * v1[e])); } }
                    u32x4 w; w.x = cvt_pk_bf16(v0[0], v0[1]); w.y = cvt_pk_bf16(v0[2], v0[3]); w.z = cvt_pk_bf16(v1[0], v1[1]); w.w = cvt_pk_bf16(v1[2], v1[3]);
                    *(u32x4*)(rowp + bj * HALF) = w; } }
    }
};
struct EpiResid {
    static constexpr bool PERM = false, AFTER_DRAIN = false;
    const float* base; float* out; int ldc; const float* gate;
    __device__ __forceinline__ void operator()(const f32x4 (&acc)[2][2][4][2], const Unit& u, int wr, int wc, int fr, int fq) const {
        const int row0 = u.pm * BM + wr * 64 + fr, col0 = u.pn * BM + wc * 32 + 4 * fq;
        const float* gp = gate + (size_t)(u.pm >> 3) * 3072 + col0;
        f32x4 gv[2][2];
#pragma unroll
        for (int bj = 0; bj < 2; ++bj)
#pragma unroll
            for (int n = 0; n < 2; ++n) gv[bj][n] = *(const f32x4*)(gp + bj * HALF + n * 16);
#pragma unroll
        for (int ai = 0; ai < 2; ++ai)
#pragma unroll
            for (int m = 0; m < 4; ++m) { const size_t off = (size_t)(row0 + ai * HALF + m * 16) * ldc + col0;
#pragma unroll
                for (int bj = 0; bj < 2; ++bj)
#pragma unroll
                    for (int n = 0; n < 2; ++n) { const f32x4 bs = *(const f32x4*)(base + off + bj * HALF + n * 16); *(f32x4*)(out + off + bj * HALF + n * 16) = bs + gv[bj][n] * acc[ai][bj][m][n]; }
                if (m & 1) asm volatile("" ::: "memory"); }
    }
};

template <class Epi, class Sched, bool ALIGN_EPI = false, bool SP2 = false>
__device__ __forceinline__ void gemm_phase(PG8_LAS unsigned char* lds, const Gemm g, const Sched& S, const Epi& E) {
    int tid_o = threadIdx.x; asm volatile("" : "+v"(tid_o));
    const int tid = tid_o, wid = __builtin_amdgcn_readfirstlane(tid >> 6), lane = tid & 63, wr = wid >> 2, wc = wid & 3, fr = lane & 15, fq = lane >> 4;
    const int K = g.K, nt = K / BK;
    unsigned voffA[2], voffB[2];
#pragma unroll
    for (int i = 0; i < 2; ++i) { int R, C; stage_rc(tid * 16 + i * 8192, R, C); const int Rb = Epi::PERM ? ((R & ~31) + perm32(R & 31)) : R;
        voffA[i] = (unsigned)(R * K + C) * 2u; voffB[i] = (unsigned)(Rb * K + C) * 2u; }
    const size_t kstep = (size_t)(BK * 2);
    const size_t hstep = (size_t)HALF * K * 2;
    const size_t tstep = 2 * hstep;
    const unsigned ldsw = (unsigned)wid * 1024u;
    const int aoff = lds_byte(wr * 64 + fr, fq * 8), boff = lds_byte(wc * 32 + fr, fq * 8);
#define PG8_SA(b, h) (((b) * 2 + (h)) * HTB)
#define PG8_SB(b, h) ((4 + (b) * 2 + (h)) * HTB)
#define PG8_STAGE(bufoff, gbase, voff) do { _Pragma("unroll") for (int _i = 0; _i < 2; ++_i) \
        __builtin_amdgcn_global_load_lds((const unsigned*)((const char*)(gbase) + (voff)[_i]), (PG8_LAS unsigned*)(lds + (bufoff) + ldsw + _i * 8192), 16, 0, 0); } while (0)
#define PG8_LDA(dst, b, h) do { _Pragma("unroll") for (int m = 0; m < 4; ++m) _Pragma("unroll") for (int k = 0; k < 2; ++k) dst[m][k] = *(const PG8_LAS bf16x8*)(lds + PG8_SA(b, h) + aoff + m * 2048 + k * 1024); } while (0)
#define PG8_LDB(dst, b, h) do { _Pragma("unroll") for (int n = 0; n < 2; ++n) _Pragma("unroll") for (int k = 0; k < 2; ++k) dst[n][k] = *(const PG8_LAS bf16x8*)(lds + PG8_SB(b, h) + boff + n * 2048 + k * 1024); } while (0)
#define PG8_MMA(ai, bj, At, Bt) do { __builtin_amdgcn_s_setprio(1); _Pragma("unroll") for (int m = 0; m < 4; ++m) _Pragma("unroll") for (int n = 0; n < 2; ++n) _Pragma("unroll") for (int k = 0; k < 2; ++k) \
        acc[ai][bj][m][n] = __builtin_amdgcn_mfma_f32_16x16x32_bf16(Bt[n][k], At[m][k], acc[ai][bj][m][n], 0, 0, 0); __builtin_amdgcn_s_setprio(0); } while (0)
#define PG8_WAIT_V(n) asm volatile("s_waitcnt vmcnt(" #n ")" ::: "memory")
#define PG8_WAIT_L(n) asm volatile("s_waitcnt lgkmcnt(" #n ")" ::: "memory")
#define PG8_BAR __builtin_amdgcn_s_barrier()
#define PG8_SCHED __builtin_amdgcn_sched_barrier(0)
    Unit cur, nxt; int ui = 0;
    if (!S.next(0, cur)) return;
    f32x4 acc[2][2][4][2];
#pragma unroll
    for (int a = 0; a < 2; ++a)
#pragma unroll
        for (int b = 0; b < 2; ++b)
#pragma unroll
            for (int m = 0; m < 4; ++m)
#pragma unroll
                for (int n = 0; n < 2; ++n) acc[a][b][m][n] = (f32x4){0.f, 0.f, 0.f, 0.f};
    bf16x8 At[4][2], B0[2][2], B1[2][2];
    const char* cA = (const char*)g.A + (size_t)cur.pm * tstep; const char* cB = (const char*)g.Bt + (size_t)cur.pn * tstep;
    S.a_ready(cur);
    if constexpr (SP2) {
        PG8_STAGE(PG8_SB(0, 0), cB, voffB); PG8_STAGE(PG8_SB(0, 1), cB + hstep, voffB); PG8_STAGE(PG8_SA(0, 0), cA, voffA); PG8_STAGE(PG8_SA(0, 1), cA + hstep, voffA);
        if (wr == 1) PG8_BAR;
        PG8_WAIT_V(2); PG8_BAR;
        PG8_STAGE(PG8_SB(1, 0), cB + kstep, voffB); PG8_STAGE(PG8_SA(1, 0), cA + kstep, voffA); PG8_STAGE(PG8_SB(1, 1), cB + hstep + kstep, voffB);
        PG8_WAIT_V(6); PG8_BAR;
    } else {
        PG8_STAGE(PG8_SB(0, 0), cB, voffB); PG8_STAGE(PG8_SA(0, 0), cA, voffA); PG8_STAGE(PG8_SB(0, 1), cB + hstep, voffB); PG8_STAGE(PG8_SA(0, 1), cA + hstep, voffA);
        if (wr == 1) PG8_BAR;
        PG8_WAIT_V(4); PG8_BAR;
        PG8_STAGE(PG8_SB(1, 0), cB + kstep, voffB); PG8_STAGE(PG8_SA(1, 0), cA + kstep, voffA); PG8_STAGE(PG8_SB(1, 1), cB + hstep + kstep, voffB);
        PG8_WAIT_V(6); PG8_BAR;
    }
    for (;;) {
        const bool has_next = S.next(ui + 1, nxt);
        const char* nA = has_next ? (const char*)g.A + (size_t)nxt.pm * tstep : cA; const char* nB = has_next ? (const char*)g.Bt + (size_t)nxt.pn * tstep : cB;
        for (int t = 0; t < nt; t += 2) {
            const bool last = (t == nt - 2);
            const char* a1 = cA + (size_t)(t + 1) * kstep;
            const char* a2 = last ? nA : cA + (size_t)(t + 2) * kstep; const char* b2 = last ? nB : cB + (size_t)(t + 2) * kstep;
            const char* a3 = a2 + kstep; const char* b3 = b2 + kstep;
            if (last && has_next) S.a_ready(nxt);
            if constexpr (SP2) {
            PG8_LDB(B0, 0, 0); PG8_LDB(B1, 0, 1); PG8_SCHED; PG8_LDA(At, 0, 0); PG8_STAGE(PG8_SA(1, 1), a1 + hstep, voffA);
            PG8_WAIT_V(8); PG8_WAIT_L(0); PG8_BAR; PG8_MMA(0, 0, At, B0); PG8_MMA(0, 1, At, B1); PG8_BAR; PG8_SCHED;
            PG8_LDA(At, 0, 1); PG8_STAGE(PG8_SB(0, 0), b2, voffB); PG8_STAGE(PG8_SB(0, 1), b2 + hstep, voffB); PG8_STAGE(PG8_SA(0, 0), a2, voffA);
            PG8_WAIT_V(8); PG8_WAIT_L(0); PG8_BAR; PG8_MMA(1, 0, At, B0); PG8_MMA(1, 1, At, B1); PG8_BAR; PG8_SCHED;
            PG8_LDB(B0, 1, 0); PG8_LDB(B1, 1, 1); PG8_SCHED; PG8_LDA(At, 1, 0); PG8_STAGE(PG8_SA(0, 1), a2 + hstep, voffA);
            PG8_WAIT_V(8); PG8_WAIT_L(0); PG8_BAR; PG8_MMA(0, 0, At, B0); PG8_MMA(0, 1, At, B1); PG8_BAR; PG8_SCHED;
            PG8_LDA(At, 1, 1); PG8_STAGE(PG8_SB(1, 0), b3, voffB); PG8_STAGE(PG8_SB(1, 1), b3 + hstep, voffB); PG8_STAGE(PG8_SA(1, 0), a3, voffA);
            PG8_WAIT_V(8); PG8_WAIT_L(0); PG8_BAR; PG8_MMA(1, 0, At, B0); PG8_MMA(1, 1, At, B1); PG8_BAR; PG8_SCHED;
            } else {
            PG8_LDB(B0, 0, 0); PG8_SCHED; PG8_LDA(At, 0, 0); PG8_STAGE(PG8_SA(1, 1), a1 + hstep, voffA);
            PG8_WAIT_L(8); PG8_BAR; PG8_WAIT_L(0); PG8_MMA(0, 0, At, B0); PG8_BAR; PG8_SCHED;
            PG8_LDB(B1, 0, 1); PG8_STAGE(PG8_SB(0, 0), b2, voffB);
            PG8_BAR; PG8_WAIT_L(0); PG8_MMA(0, 1, At, B1); PG8_BAR;
            PG8_LDA(At, 0, 1); PG8_STAGE(PG8_SA(0, 0), a2, voffA);
            PG8_BAR; PG8_WAIT_L(0); PG8_MMA(1, 0, At, B0); PG8_BAR; PG8_SCHED;
            PG8_STAGE(PG8_SB(0, 1), b2 + hstep, voffB);
            PG8_WAIT_V(6); PG8_BAR; PG8_MMA(1, 1, At, B1); PG8_BAR;
            PG8_LDB(B0, 1, 0); PG8_SCHED; PG8_LDA(At, 1, 0); PG8_STAGE(PG8_SA(0, 1), a2 + hstep, voffA);
            PG8_WAIT_L(8); PG8_BAR; PG8_WAIT_L(0); PG8_MMA(0, 0, At, B0); PG8_BAR; PG8_SCHED;
            PG8_LDB(B1, 1, 1); PG8_STAGE(PG8_SB(1, 0), b3, voffB);
            PG8_BAR; PG8_WAIT_L(0); PG8_MMA(0, 1, At, B1); PG8_BAR;
            PG8_LDA(At, 1, 1); PG8_STAGE(PG8_SA(1, 0), a3, voffA);
            PG8_BAR; PG8_WAIT_L(0); PG8_MMA(1, 0, At, B0); PG8_BAR; PG8_SCHED;
            PG8_STAGE(PG8_SB(1, 1), b3 + hstep, voffB);
            PG8_WAIT_V(6); PG8_BAR; PG8_MMA(1, 1, At, B1); PG8_BAR;
            }
        }
        if constexpr (ALIGN_EPI) { if (wr == 0) PG8_BAR; }
        if constexpr (!Epi::AFTER_DRAIN) { E(acc, cur, wr, wc, fr, fq); S.done(cur); }
        if (!has_next) break;
#pragma unroll
        for (int a = 0; a < 2; ++a)
#pragma unroll
            for (int b = 0; b < 2; ++b)
#pragma unroll
                for (int m = 0; m < 4; ++m)
#pragma unroll
                    for (int n = 0; n < 2; ++n) acc[a][b][m][n] = (f32x4){0.f, 0.f, 0.f, 0.f};
        cur = nxt; cA = nA; cB = nB; ++ui;
        if constexpr (ALIGN_EPI) { if (wr == 1) PG8_BAR; }
    }
    PG8_WAIT_V(0);
    if constexpr (!ALIGN_EPI) { if (wr == 0) PG8_BAR; }
    PG8_BAR;
    if constexpr (Epi::AFTER_DRAIN) { E.fused(acc, cur, wr, wc, fr, fq, lds, wid, lane); S.done(cur); }
#undef PG8_SA
#undef PG8_SB
#undef PG8_STAGE
#undef PG8_LDA
#undef PG8_LDB
#undef PG8_MMA
#undef PG8_WAIT_V
#undef PG8_WAIT_L
#undef PG8_BAR
#undef PG8_SCHED
}
}
#define GAS __attribute__((address_space(1)))
#define LAS __attribute__((address_space(3)))
typedef unsigned short bf16;
typedef unsigned v4u __attribute__((ext_vector_type(4)));
typedef float f32x4 __attribute__((ext_vector_type(4)));
typedef short bf16x8 __attribute__((ext_vector_type(8)));
typedef GAS unsigned gu32;
typedef GAS unsigned long long gu64;
#define RLX_AGENT __ATOMIC_RELAXED, __HIP_MEMORY_SCOPE_AGENT
#define LDS_WAIT() asm volatile("s_waitcnt lgkmcnt(0)" ::: "memory")
#define VM_WAIT() asm volatile("s_waitcnt vmcnt(0)" ::: "memory")
__device__ __forceinline__ unsigned long long rt() { return __builtin_amdgcn_s_memrealtime(); }
__device__ __forceinline__ unsigned f2bf(float f) { unsigned u = __builtin_bit_cast(unsigned, f); return (u + 0x7fffu + ((u >> 16) & 1u)) >> 16; }
__device__ __forceinline__ unsigned pk2(float lo, float hi) { return f2bf(lo) | (f2bf(hi) << 16); }

#define XB_TMO      128
#define XB_XCNT(j)  (256  + 64 * (j))
#define XB_XSUB(j)  (1280 + 64 * (j))
#define XB_XGEN(j)  (2304 + 64 * (j))
#define XB_TOP      3328
#define XB_TOPGEN   3392
#define XCD_BAR_WORDS 3456
#define XB_SPIN_CAP (1u << 18)

__device__ __forceinline__ unsigned xb_ld(unsigned* p)              { return __hip_atomic_load(p, __ATOMIC_RELAXED, __HIP_MEMORY_SCOPE_AGENT); }
__device__ __forceinline__ unsigned xb_add(unsigned* p, unsigned v) { return __hip_atomic_fetch_add(p, v, __ATOMIC_RELAXED, __HIP_MEMORY_SCOPE_AGENT); }
__device__ __forceinline__ unsigned xb_xcc_id() { return (unsigned)__builtin_amdgcn_s_getreg((3 << 11) | 20) & 0xFu; }
#define XB_SPIN(cond, bar) do { unsigned _sp = 0; while (cond) { __builtin_amdgcn_s_sleep(1); \
    if ((++_sp & 255u) == 0u) { if (xb_ld(&(bar)[XB_TMO])) break; if (_sp > XB_SPIN_CAP) { atomicAdd(&(bar)[XB_TMO], 1u); break; } } } } while (0)

struct XcdBarrier {
    unsigned* bar; unsigned x;
    volatile LAS unsigned* st;
};

__device__ __forceinline__ XcdBarrier xcd_barrier_post(unsigned* bar, volatile LAS unsigned* st) {
    XcdBarrier b; b.bar = bar; b.x = xb_xcc_id(); b.st = st;
    if (threadIdx.x == 0) (void)xb_add(&bar[XB_XCNT(b.x)], 1u);
    return b;
}
__device__ __forceinline__ void xcd_barrier_complete(unsigned* bar, unsigned x, unsigned& nloc, unsigned& nx) {
    const unsigned G = gridDim.x * gridDim.y * gridDim.z;
    unsigned sum, cnt, mine, sp = 0u;
    for (;;) {
        sum = 0u; cnt = 0u; mine = 0u;
#pragma unroll
        for (unsigned j = 0; j < 16; ++j) { const unsigned c = xb_ld(&bar[XB_XCNT(j)]); sum += c; cnt += (c > 0u) ? 1u : 0u; mine = (j == x) ? c : mine; }
        if (sum == G) break;
        __builtin_amdgcn_s_sleep(1);
        if ((++sp & 255u) == 0u) { if (xb_ld(&bar[XB_TMO])) break; if (sp > XB_SPIN_CAP) { atomicAdd(&bar[XB_TMO], 1u); break; } }
    }
    nloc = mine > 0u ? mine : 1u; nx = cnt > 0u ? cnt : 1u;
}

__device__ __forceinline__ void xcd_barrier(const XcdBarrier& b) {
    asm volatile("s_waitcnt vmcnt(0)" ::: "memory");
    __syncthreads();
    if (threadIdx.x == 0) {
        unsigned* bar = b.bar;
        __builtin_amdgcn_s_waitcnt(0);
        unsigned nloc = b.st[0], nx = b.st[1];
        if (nloc == 0u) { xcd_barrier_complete(bar, b.x, nloc, nx); b.st[0] = nloc; b.st[1] = nx; }
        const unsigned old = xb_add(&bar[XB_XSUB(b.x)], 1u);
        const unsigned gen = old / nloc;
        if (old + 1u == (gen + 1u) * nloc) {
            __builtin_amdgcn_fence(__ATOMIC_RELEASE, "agent");
            asm volatile("s_waitcnt vmcnt(0)" ::: "memory");
            const unsigned og = xb_add(&bar[XB_TOP], 1u);
            const unsigned tg = og / nx;
            if (og + 1u == (tg + 1u) * nx) xb_add(&bar[XB_TOPGEN], 1u);
            else XB_SPIN(xb_ld(&bar[XB_TOPGEN]) == tg, bar);
            __builtin_amdgcn_fence(__ATOMIC_ACQUIRE, "agent");
            xb_add(&bar[XB_XGEN(b.x)], 1u);
            asm volatile("s_waitcnt vmcnt(0)" ::: "memory");
        } else {
            XB_SPIN(xb_ld(&bar[XB_XGEN(b.x)]) == gen, bar);
            __builtin_amdgcn_fence(__ATOMIC_ACQUIRE, "agent");
            asm volatile("s_waitcnt vmcnt(0)" ::: "memory");
        }
    }
    __syncthreads();
}

constexpr int NWAVES = 8;
constexpr int BATCH = 16, SEQ = 2048, D = 1024, M = BATCH * SEQ;
constexpr int GLA_IN = 3088, N0 = 3072;
constexpr int DSW_IN = 10240, NQKV1 = 9216;
constexpr int NPART = 4, MP = M / NPART;
constexpr float EPS = 1e-6f, LOG2E = 1.4426950408889634f;
constexpr float QSCALE0 = 0.08838834764831845f;
constexpr float QSCALE1 = 0.125f * LOG2E;

constexpr size_t MiB = 1u << 20;
constexpr size_t WS_CTL = 0, CTL_ZERO_BYTES = 1 * MiB;
constexpr size_t WS_MOD = 1 * MiB;
constexpr size_t WS_BIAS = 1 * MiB + 512 * 1024;
constexpr size_t WS_WT0 = 2 * MiB, WS_WT1 = 8 * MiB, WS_WTO0 = 28 * MiB, WS_WTO1 = 30 * MiB;
constexpr size_t WS_XN = 32 * MiB;
constexpr size_t WS_XN2 = 96 * MiB;
constexpr size_t WS_BIG = 160 * MiB;
constexpr size_t WS_QKVR = WS_BIG;
constexpr size_t WS_SSQ = WS_BIG + 274 * MiB;
constexpr size_t WS_GLR = WS_BIG + 276 * MiB;
constexpr size_t WS_QKV1 = WS_BIG;
constexpr size_t WS_OG = WS_BIG + 144 * MiB;
constexpr size_t WS_LSE = WS_BIG + 192 * MiB;
constexpr size_t WS_GATE = WS_BIG + 196 * MiB;
constexpr size_t WS_END = WS_BIG + 280 * MiB;
constexpr int CW_BAR = 4096;

constexpr int RING_OFF = 0, RING_BYTES = 131072;
constexpr int LDSCTL_OFF = RING_BYTES, MISC_OFF = LDSCTL_OFF + 320;
constexpr int LDS_BYTES = 147456;

template <class T> __device__ __forceinline__ T* as_global(T* p) { return (T*)(GAS T*)p; }
__device__ __forceinline__ float bf2f(bf16 b) { return __uint_as_float((unsigned)b << 16); }
__device__ __forceinline__ float wave_sum(float v) {
#pragma unroll
    for (int o = 1; o < 64; o <<= 1) v += __shfl_xor(v, o);
    return v;
}
__device__ __forceinline__ float wave_max(float v) {
#pragma unroll
    for (int o = 1; o < 64; o <<= 1) v = fmaxf(v, __shfl_xor(v, o));
    return v;
}
__device__ __forceinline__ float silu_f(float v) { return v / (1.f + __expf(-v)); }

__device__ __forceinline__ void transpose_item(const float* W, int ldw, int scol0, int K, bf16* WT, int drow0, LAS float* scr, int kb, int nb, int lane) {
    const int k0 = 64 * kb, n0 = 32 * nb;
#pragma unroll 8
    for (int i = 0; i < 32; ++i) { const int kk = 2 * i + (lane >> 5); scr[kk * 33 + (lane & 31)] = W[(size_t)(k0 + kk) * ldw + scol0 + n0 + (lane & 31)]; }
    LDS_WAIT(); asm volatile("" ::: "memory");
    const int c = lane & 7;
#pragma unroll
    for (int j = 0; j < 4; ++j) { const int n = (lane >> 3) + 8 * j; const LAS float* s = scr + (8 * c) * 33 + n;
        v4u o; o.x = pk2(s[0 * 33], s[1 * 33]); o.y = pk2(s[2 * 33], s[3 * 33]); o.z = pk2(s[4 * 33], s[5 * 33]); o.w = pk2(s[6 * 33], s[7 * 33]);
        *(GAS v4u*)(WT + (size_t)(drow0 + n0 + n) * K + k0 + 8 * c) = o; }
    LDS_WAIT(); asm volatile("" ::: "memory");
}
__device__ __forceinline__ int t5_bucket(int n) {
    if (n < 16) return n;
    int b = 16;
    b += (n >= 22); b += (n >= 30); b += (n >= 40); b += (n >= 54); b += (n >= 73); b += (n >= 99); b += (n >= 134); b += (n >= 182);
    b += (n >= 246); b += (n >= 332); b += (n >= 450); b += (n >= 609); b += (n >= 825); b += (n >= 1117); b += (n >= 1513);
    return b;
}

__device__ __forceinline__ float reduce16(const float (&a)[16], int lane, int& col) {
    float b8[8], b4[4], b2[2], b1;
    const bool h5 = (lane & 32) != 0, h4 = (lane & 16) != 0, h3 = (lane & 8) != 0, h2 = (lane & 4) != 0;
#pragma unroll
    for (int c = 0; c < 8; ++c) { const float keep = h5 ? a[c + 8] : a[c], send = h5 ? a[c] : a[c + 8]; b8[c] = keep + __shfl_xor(send, 32); }
#pragma unroll
    for (int c = 0; c < 4; ++c) { const float keep = h4 ? b8[c + 4] : b8[c], send = h4 ? b8[c] : b8[c + 4]; b4[c] = keep + __shfl_xor(send, 16); }
#pragma unroll
    for (int c = 0; c < 2; ++c) { const float keep = h3 ? b4[c + 2] : b4[c], send = h3 ? b4[c] : b4[c + 2]; b2[c] = keep + __shfl_xor(send, 8); }
    { const float keep = h2 ? b2[1] : b2[0], send = h2 ? b2[0] : b2[1]; b1 = keep + __shfl_xor(send, 4); }
    b1 += __shfl_xor(b1, 2); b1 += __shfl_xor(b1, 1);
    col = (h5 ? 8 : 0) + (h4 ? 4 : 0) + (h3 ? 2 : 0) + (h2 ? 1 : 0);
    return b1;
}

struct Args { const float* in[14]; float* out; unsigned char* ws; int ph_lo, ph_hi, li, pad; };
constexpr int N_PHASES = 18;
#ifndef MK_N_LAUNCHES
#define MK_N_LAUNCHES 1
#endif
constexpr int N_LAUNCHES = MK_N_LAUNCHES;

__global__ void __launch_bounds__(NWAVES * 64, 2) mk_fwd(Args args) {
    extern __shared__ __attribute__((aligned(16))) unsigned char lds_raw[];
    LAS unsigned char* lds = (LAS unsigned char*)lds_raw;
    volatile LAS unsigned* MISC = (volatile LAS unsigned*)(lds + MISC_OFF);
    const int G = gridDim.x; const int bx = blockIdx.x; const int vcu0 = (G % 8 == 0) ? (bx % 8) * (G / 8) + bx / 8 : bx;
    const int NGW = G * NWAVES;
#define KA_LOAD() \
    int tid = threadIdx.x; asm volatile("" : "+v"(tid)); const int lane = tid & 63, wave = __builtin_amdgcn_readfirstlane(tid >> 6); \
    int vcu = vcu0; asm volatile("" : "+s"(vcu)); const int gw = vcu * NWAVES + wave; (void)lane; (void)gw; \
    const __attribute__((address_space(4))) Args* ka_ = (const __attribute__((address_space(4))) Args*)__builtin_amdgcn_kernarg_segment_ptr(); asm volatile("" : "+s"(ka_)); \
    unsigned char* ws = as_global(ka_->ws); float* out = as_global(ka_->out); (void)ws; (void)out; \
    const float* x = as_global(ka_->in[0]); const float* cvec = as_global(ka_->in[1]); const float* ada_w = as_global(ka_->in[2]); const float* ada_b = as_global(ka_->in[3]); const float* norm_g = as_global(ka_->in[4]); \
    const float* gla_w_in = as_global(ka_->in[5]); const float* gla_w_alpha = as_global(ka_->in[6]); const float* gla_b_alpha = as_global(ka_->in[7]); const float* gla_norm_g = as_global(ka_->in[8]); \
    const float* gla_w_out = as_global(ka_->in[9]); const float* dsw_w_in = as_global(ka_->in[10]); const float* dsw_w_out = as_global(ka_->in[11]); const float* rel_bias = as_global(ka_->in[12]); const float* final_g = as_global(ka_->in[13]); \
    (void)x; (void)cvec; (void)ada_w; (void)ada_b; (void)norm_g; (void)gla_w_in; (void)gla_w_alpha; (void)gla_b_alpha; (void)gla_norm_g; (void)gla_w_out; (void)dsw_w_in; (void)dsw_w_out; (void)rel_bias; (void)final_g; \
    float* MOD = (float*)(ws + WS_MOD); float* BIAS = (float*)(ws + WS_BIAS); (void)MOD; (void)BIAS; \
    bf16* WT0 = (bf16*)(ws + WS_WT0); bf16* WT1 = (bf16*)(ws + WS_WT1); bf16* WTO0 = (bf16*)(ws + WS_WTO0); bf16* WTO1 = (bf16*)(ws + WS_WTO1); (void)WT0; (void)WT1; (void)WTO0; (void)WTO1; \
    bf16* XN = (bf16*)(ws + WS_XN); bf16* XN2 = (bf16*)(ws + WS_XN2); bf16* QKVR = (bf16*)(ws + WS_QKVR); (void)XN; (void)XN2; (void)QKVR; \
    float* SSQ = (float*)(ws + WS_SSQ); float* GLR = (float*)(ws + WS_GLR); (void)SSQ; (void)GLR; \
    bf16* QKV1 = (bf16*)(ws + WS_QKV1); bf16* OG = (bf16*)(ws + WS_OG); float* LSE = (float*)(ws + WS_LSE); bf16* GATE = (bf16*)(ws + WS_GATE); (void)QKV1; (void)OG; (void)LSE; (void)GATE;
    gu32* ctl = (gu32*)(args.ws + WS_CTL);

    for (int u = threadIdx.x; u < (LDS_BYTES - LDSCTL_OFF) / 4; u += NWAVES * 64) ((LAS unsigned*)(lds + LDSCTL_OFF))[u] = 0u;
    __syncthreads();
    XcdBarrier bar; bar.bar = (unsigned*)(ctl + CW_BAR); bar.x = 0; bar.st = nullptr;
    if (N_LAUNCHES == 1) bar = xcd_barrier_post((unsigned*)(ctl + CW_BAR), MISC + 8);
#define GRID_BAR() do { if (N_LAUNCHES == 1) xcd_barrier(bar); } while (0)
    const int lo = args.ph_lo, hi = args.ph_hi;
#define IN(k) (lo <= (k) && (k) < hi)
#define BOTH(k) (IN(k) && IN((k) + 1))

    if (IN(0)) { KA_LOAD();
        {
            LAS float* scr = (LAS float*)(lds + RING_OFF + wave * 16384);
            for (int it = gw; it < 7680; it += NGW) {
                int r = it;
                if (r < 1024) { transpose_item(gla_w_in, GLA_IN, 0, D, WT0, 0, scr, r / 64, r % 64, lane); continue; } r -= 1024;
                if (r < 512) { transpose_item(gla_w_in, GLA_IN, 2064, D, WT0, 2048, scr, r / 32, r % 32, lane); continue; } r -= 512;
                if (r < 5120) { transpose_item(dsw_w_in, DSW_IN, 0, D, WT1, 0, scr, r / 320, r % 320, lane); continue; } r -= 5120;
                if (r < 512) { transpose_item(gla_w_out, D, 0, D, WTO0, 0, scr, r / 32, r % 32, lane); continue; } r -= 512;
                transpose_item(dsw_w_out, D, 0, D, WTO1, 0, scr, r / 32, r % 32, lane);
            }
        }
        __syncthreads();
        if (vcu < 96) {
            const int layer = vcu / 48, cb = vcu % 48, col = cb * 64 + lane;
            LAS float* sc = (LAS float*)lds;
            LAS float* red = (LAS float*)(lds + 65536);
            for (int i = 0; i < 32; ++i) { const int idx = i * 512 + tid, b = idx >> 10, k = idx & 1023; sc[k * 16 + b] = silu_f(cvec[idx]); }
            __syncthreads();
            float acc[16];
#pragma unroll
            for (int b = 0; b < 16; ++b) acc[b] = 0.f;
            const float* wp = ada_w + (size_t)layer * D * 3072 + (size_t)(wave * 128) * 3072 + col;
#pragma unroll 4
            for (int kk = 0; kk < 128; ++kk) { const float w = wp[(size_t)kk * 3072]; const LAS f32x4* s4 = (const LAS f32x4*)(sc + (wave * 128 + kk) * 16);
#pragma unroll
                for (int q = 0; q < 4; ++q) { const f32x4 s = s4[q]; acc[4 * q + 0] += s[0] * w; acc[4 * q + 1] += s[1] * w; acc[4 * q + 2] += s[2] * w; acc[4 * q + 3] += s[3] * w; } }
#pragma unroll
            for (int b = 0; b < 16; ++b) red[(wave * 16 + b) * 64 + lane] = acc[b];
            __syncthreads();
            for (int r = 0; r < 2; ++r) { const int idx = tid + r * 512, b = idx >> 6, cl = idx & 63; float s = 0.f;
#pragma unroll
                for (int w = 0; w < 8; ++w) s += red[(w * 16 + b) * 64 + cl];
                MOD[(size_t)(layer * 16 + b) * 3072 + cb * 64 + cl] = s + ada_b[layer * 3072 + cb * 64 + cl]; }
            __syncthreads();
        }
        if (vcu == G - 1) {
            for (int idx = tid; idx < 3 * 16 * 132; idx += NWAVES * 64) { const int g = idx / (16 * 132), h = (idx / 132) % 16, s = idx % 132; const int dil = g == 0 ? 1 : (g == 1 ? 4 : 16);
                BIAS[idx] = (s <= 128) ? rel_bias[t5_bucket(s * dil) * 16 + h] * LOG2E : 0.f; }
        }
        if (BOTH(0)) GRID_BAR();
    }

#define PRENORM(Xsrc, layer, WITH_GLR) do { \
        LAS float* wlr = (LAS float*)lds; \
        if (WITH_GLR) { for (int idx = tid; idx < 16384; idx += NWAVES * 64) { const int k = idx >> 4, c = idx & 15; wlr[c * 1028 + k] = gla_w_in[(size_t)k * GLA_IN + 2048 + c]; } __syncthreads(); } \
        const int b_ = gw >> 7; const float* mod_ = MOD + (size_t)((layer) * 16 + b_) * 3072; const float* gv_ = norm_g + (layer) * D; \
        f32x4 gs[4], sh[4]; \
        _Pragma("unroll") for (int j = 0; j < 4; ++j) { const int col = 256 * j + 4 * lane; const f32x4 g4 = *(const f32x4*)(gv_ + col), sc4 = *(const f32x4*)(mod_ + 1024 + col); sh[j] = *(const f32x4*)(mod_ + col); gs[j] = g4 * (1.f + sc4); } \
        for (int r = 0; r < 16; ++r) { asm volatile("" ::: "memory"); const size_t row = (size_t)gw * 16 + r; const float* xr = (Xsrc) + row * D; \
            f32x4 v[4]; float ss = 0.f; \
            _Pragma("unroll") for (int j = 0; j < 4; ++j) { v[j] = *(const f32x4*)(xr + 256 * j + 4 * lane); ss += (v[j][0] * v[j][0] + v[j][1] * v[j][1]) + (v[j][2] * v[j][2] + v[j][3] * v[j][3]); } \
            const float rstd = 1.0f / sqrtf(wave_sum(ss) * (1.f / D) + EPS); \
            _Pragma("unroll") for (int j = 0; j < 4; ++j) { v[j] = v[j] * rstd * gs[j] + sh[j]; \
                *(unsigned long long*)(XN + row * D + 256 * j + 4 * lane) = (unsigned long long)pk2(v[j][0], v[j][1]) | ((unsigned long long)pk2(v[j][2], v[j][3]) << 32); } \
            if (WITH_GLR) { float acc[16]; \
                _Pragma("unroll") for (int c = 0; c < 16; ++c) { float a = 0.f; \
                    _Pragma("unroll") for (int j = 0; j < 4; ++j) { const f32x4 w4 = *(const LAS f32x4*)(wlr + c * 1028 + 256 * j + 4 * lane); a += (v[j][0] * w4[0] + v[j][1] * w4[1]) + (v[j][2] * w4[2] + v[j][3] * w4[3]); } \
                    acc[c] = a; } \
                int col_; const float sres = reduce16(acc, lane, col_); if ((lane & 3) == 0) GLR[row * 16 + col_] = sres; } \
        } } while (0)

    if (IN(1)) { KA_LOAD(); PRENORM(x, 0, true); if (BOTH(1)) GRID_BAR(); }

    if (IN(2)) { KA_LOAD();
        pg8::Gemm g{XN, WT0, M, N0, D}; pg8::StaticOrder S; S.init(M, N0, G, bx);
        pg8::EpiBf16S E{QKVR, N0, 2, QSCALE0};
        pg8::gemm_phase<pg8::EpiBf16S, pg8::StaticOrder, true, true>(lds + RING_OFF, g, S, E);
        if (BOTH(2)) GRID_BAR();
    }

    if (IN(3)) { KA_LOAD();
        bf16* O = XN;
        LAS float* a_s = (LAS float*)lds; LAS float* q_s = a_s + 2048; LAS float* k_s = q_s + 2048; LAS float* v_s = k_s + 2048; LAS float* red = v_s + 1024;
        for (int item = vcu; item < 256; item += G) {
            const int b = item >> 4, h = (item >> 2) & 3, dvs = item & 3;
            const int d = tid & 127, tq = tid >> 7, e = tid & 63;
            float wa[16];
#pragma unroll
            for (int i = 0; i < 16; ++i) wa[i] = gla_w_alpha[i * 512 + h * 128 + d];
            const float ba = gla_b_alpha[h * 128 + d];
            float S[16];
#pragma unroll
            for (int i = 0; i < 16; ++i) S[i] = 0.f;
            for (int blk = 0; blk < 128; ++blk) {
                const size_t row0 = (size_t)b * SEQ + blk * 16;
#pragma unroll
                for (int u = 0; u < 4; ++u) { const int t = tq * 4 + u; const size_t row = row0 + t; const float* gl = GLR + row * 16; float z = ba;
#pragma unroll
                    for (int i = 0; i < 16; ++i) z += gl[i] * wa[i];
                    const float ls = fminf(z, 0.f) - log1pf(expf(-fabsf(z)));
                    a_s[t * 128 + d] = expf(ls * (1.f / 16.f));
                    q_s[t * 128 + d] = bf2f(QKVR[row * N0 + h * 128 + d]);
                    k_s[t * 128 + d] = bf2f(QKVR[row * N0 + 512 + h * 128 + d]); }
#pragma unroll
                for (int u = 0; u < 2; ++u) { const int idx = tid + u * 512, t = idx >> 6, ee = idx & 63; v_s[idx] = bf2f(QKVR[(row0 + t) * N0 + 1024 + h * 256 + dvs * 64 + ee]); }
                __syncthreads();
                for (int t = 0; t < 16; ++t) { const float v = v_s[t * 64 + e]; float po = 0.f;
#pragma unroll
                    for (int i4 = 0; i4 < 4; ++i4) { const f32x4 a4 = *(const LAS f32x4*)(a_s + t * 128 + wave * 16 + 4 * i4), k4 = *(const LAS f32x4*)(k_s + t * 128 + wave * 16 + 4 * i4), q4 = *(const LAS f32x4*)(q_s + t * 128 + wave * 16 + 4 * i4);
#pragma unroll
                        for (int ii = 0; ii < 4; ++ii) { S[4 * i4 + ii] = a4[ii] * S[4 * i4 + ii] + k4[ii] * v; po += q4[ii] * S[4 * i4 + ii]; } }
                    red[(t * 8 + wave) * 64 + e] = po; }
                __syncthreads();
#pragma unroll
                for (int u = 0; u < 2; ++u) { const int t = wave + 8 * u; float o = 0.f;
#pragma unroll
                    for (int w = 0; w < 8; ++w) o += red[(t * 8 + w) * 64 + e];
                    const size_t row = row0 + t; O[row * D + h * 256 + dvs * 64 + e] = (bf16)f2bf(o);
                    const float ss = wave_sum(o * o); if (lane == 0) SSQ[row * 16 + h * 4 + dvs] = ss; }
            }
            __syncthreads();
        }
        if (BOTH(3)) GRID_BAR();
    }

    if (IN(4)) { KA_LOAD();
        const bf16* O = XN;
        const f32x4 g4 = *(const f32x4*)(gla_norm_g + 4 * lane);
        for (int r = 0; r < 16; ++r) { const size_t row = (size_t)gw * 16 + r;
#pragma unroll
            for (int j = 0; j < 4; ++j) { const int col = 256 * j + 4 * lane;
                const f32x4 s4 = *(const f32x4*)(SSQ + row * 16 + 4 * j); const float rstd = 1.0f / sqrtf(((s4[0] + s4[1]) + (s4[2] + s4[3])) * (1.f / 256.f) + EPS);
                const unsigned long long ob = *(const unsigned long long*)(O + row * D + col), rb = *(const unsigned long long*)(QKVR + row * N0 + 2048 + col);
                float o[4], rr[4];
#pragma unroll
                for (int i = 0; i < 4; ++i) { o[i] = bf2f((bf16)(ob >> (16 * i))); rr[i] = bf2f((bf16)(rb >> (16 * i))); o[i] = o[i] * rstd * g4[i] * silu_f(rr[i]); }
                *(unsigned long long*)(XN2 + row * D + col) = (unsigned long long)pk2(o[0], o[1]) | ((unsigned long long)pk2(o[2], o[3]) << 32); } }
        if (BOTH(4)) GRID_BAR();
    }

    if (IN(5)) { KA_LOAD();
        pg8::Gemm g{XN2, WTO0, M, D, D}; pg8::StaticOrder S; S.init(M, D, G, bx);
        pg8::EpiResid E{x, out, D, MOD + 2048};
        pg8::gemm_phase<pg8::EpiResid, pg8::StaticOrder, true, true>(lds + RING_OFF, g, S, E);
        if (BOTH(5)) GRID_BAR();
    }

    if (IN(6)) { KA_LOAD(); PRENORM(out, 1, false); if (BOTH(6)) GRID_BAR(); }

    for (int p = 0; p <= NPART; ++p) {
        const int kA = 7 + 2 * p;
        if (IN(kA)) { KA_LOAD();
            if (p > 0) {
                const size_t prow0 = (size_t)(p - 1) * MP;
                for (int r = 0; r < 4; ++r) { const size_t row = (size_t)gw * 4 + r;
#pragma unroll
                    for (int j = 0; j < 4; ++j) { const int col = 256 * j + 4 * lane, hh = col >> 6;
                        const float l0 = LSE[(0 * (size_t)MP + row) * 16 + hh], l1 = LSE[(1 * (size_t)MP + row) * 16 + hh], l2 = LSE[(2 * (size_t)MP + row) * 16 + hh];
                        const float mx = fmaxf(l0, fmaxf(l1, l2)); float w0 = exp2f(l0 - mx), w1 = exp2f(l1 - mx), w2 = exp2f(l2 - mx); const float inv = 1.f / (w0 + w1 + w2); w0 *= inv; w1 *= inv; w2 *= inv;
                        const unsigned long long o0 = *(const unsigned long long*)(OG + (0 * (size_t)MP + row) * D + col), o1 = *(const unsigned long long*)(OG + (1 * (size_t)MP + row) * D + col), o2 = *(const unsigned long long*)(OG + (2 * (size_t)MP + row) * D + col);
                        const unsigned long long gb = *(const unsigned long long*)(GATE + (prow0 + row) * D + col);
                        float o[4];
#pragma unroll
                        for (int i = 0; i < 4; ++i) o[i] = (w0 * bf2f((bf16)(o0 >> (16 * i))) + w1 * bf2f((bf16)(o1 >> (16 * i))) + w2 * bf2f((bf16)(o2 >> (16 * i)))) * bf2f((bf16)(gb >> (16 * i)));
                        *(unsigned long long*)(XN2 + (prow0 + row) * D + col) = (unsigned long long)pk2(o[0], o[1]) | ((unsigned long long)pk2(o[2], o[3]) << 32); } }
            }
            if (p < NPART) {
                pg8::Gemm g{XN + (size_t)p * MP * D, WT1, MP, DSW_IN, D}; pg8::StaticOrder S; S.init(MP, DSW_IN, G, bx);
                pg8::EpiQkvGate E{QKV1, GATE + (size_t)p * MP * D, QSCALE1};
                pg8::gemm_phase<pg8::EpiQkvGate, pg8::StaticOrder, true, true>(lds + RING_OFF, g, S, E);
            }
            if (BOTH(kA)) GRID_BAR();
        }
        const int kB = 8 + 2 * p;
        if (p < NPART && IN(kB)) { KA_LOAD();
            for (int task = gw; task < 3 * MP * 16; task += NGW) {
                const int h = task & 15, row = (task >> 4) % MP, g = task / (MP * 16);
                const int t = row & (SEQ - 1); const int dil = g == 0 ? 1 : (g == 1 ? 4 : 16); const int i = t / dil; const int nk = (i < 128 ? i : 128) + 1;
                const bf16* qp = QKV1 + (size_t)row * NQKV1 + g * 3072 + h * 64;
                float q[64];
#pragma unroll
                for (int c = 0; c < 8; ++c) { const v4u w = *(const v4u*)(qp + 8 * c);
#pragma unroll
                    for (int e = 0; e < 4; ++e) { q[8 * c + 2 * e] = __uint_as_float(w[e] << 16); q[8 * c + 2 * e + 1] = __uint_as_float(w[e] & 0xffff0000u); } }
                const float* bp = BIAS + (g * 16 + h) * 132;
                float s[3];
#pragma unroll
                for (int ps = 0; ps < 3; ++ps) { const int j = ps * 64 + lane; s[ps] = -INFINITY;
                    if (j < nk) { const bf16* kp = QKV1 + (size_t)(row - j * dil) * NQKV1 + g * 3072 + 1024 + h * 64; float dsum = 0.f;
#pragma unroll
                        for (int c = 0; c < 8; ++c) { const v4u w = *(const v4u*)(kp + 8 * c);
#pragma unroll
                            for (int e = 0; e < 4; ++e) dsum += q[8 * c + 2 * e] * __uint_as_float(w[e] << 16) + q[8 * c + 2 * e + 1] * __uint_as_float(w[e] & 0xffff0000u); }
                        s[ps] = dsum + bp[j]; } }
                const float mx = wave_max(fmaxf(s[0], fmaxf(s[1], s[2])));
                const float p0 = exp2f(s[0] - mx), p1 = exp2f(s[1] - mx), p2 = exp2f(s[2] - mx);
                const float l = wave_sum(p0 + p1 + p2);
                float o = 0.f; const bf16* vp = QKV1 + (size_t)row * NQKV1 + g * 3072 + 2048 + h * 64 + lane;
                for (int j = 0; j < nk; ++j) { const float pj = __shfl(j < 64 ? p0 : (j < 128 ? p1 : p2), j & 63); o += pj * bf2f(vp[-(long)j * dil * NQKV1]); }
                OG[((size_t)g * MP + row) * D + h * 64 + lane] = (bf16)f2bf(o / l);
                if (lane == 0) LSE[((size_t)g * MP + row) * 16 + h] = mx + log2f(l);
            }
            if (BOTH(kB)) GRID_BAR();
        }
    }

    if (IN(16)) { KA_LOAD();
        pg8::Gemm g{XN2, WTO1, M, D, D}; pg8::StaticOrder S; S.init(M, D, G, bx);
        pg8::EpiResid E{out, out, D, MOD + (size_t)16 * 3072 + 2048};
        pg8::gemm_phase<pg8::EpiResid, pg8::StaticOrder, true, true>(lds + RING_OFF, g, S, E);
        if (BOTH(16)) GRID_BAR();
    }

    if (IN(17)) { KA_LOAD();
        f32x4 fg[4];
#pragma unroll
        for (int j = 0; j < 4; ++j) fg[j] = *(const f32x4*)(final_g + 256 * j + 4 * lane);
        for (int r = 0; r < 16; ++r) { const size_t row = (size_t)gw * 16 + r; float* xr = out + row * D;
            f32x4 v[4]; float ss = 0.f;
#pragma unroll
            for (int j = 0; j < 4; ++j) { v[j] = *(const f32x4*)(xr + 256 * j + 4 * lane); ss += (v[j][0] * v[j][0] + v[j][1] * v[j][1]) + (v[j][2] * v[j][2] + v[j][3] * v[j][3]); }
            const float rstd = 1.0f / sqrtf(wave_sum(ss) * (1.f / D) + EPS);
#pragma unroll
            for (int j = 0; j < 4; ++j) *(f32x4*)(xr + 256 * j + 4 * lane) = v[j] * rstd * fg[j]; }
    }
#undef IN
#undef BOTH
#undef GRID_BAR
#undef PRENORM
#undef KA_LOAD
}

extern "C" void kernel_launch(void* const* d_in, const int* in_sizes, int n_in, void* d_out, int out_size, void* d_ws, size_t ws_size, hipStream_t stream) {
    static int grid = 0;
    if (grid == 0) {
        if (n_in != 14 || in_sizes[0] != M * D || out_size != M * D || ws_size < WS_END) { fprintf(stderr, "kernel_launch: unexpected problem shape / workspace (n_in %d, in0 %d, out %d, ws %zu < %zu); nothing launched\n", n_in, n_in > 0 ? in_sizes[0] : -1, out_size, ws_size, (size_t)WS_END); grid = -1; return; }
        int dev = 0, cus = 0, per_cu = 0;
        if (hipGetDevice(&dev) != hipSuccess || hipDeviceGetAttribute(&cus, hipDeviceAttributeMultiprocessorCount, dev) != hipSuccess) { fprintf(stderr, "kernel_launch: device query failed\n"); grid = -1; return; }
        if (hipFuncSetAttribute((const void*)mk_fwd, hipFuncAttributeMaxDynamicSharedMemorySize, LDS_BYTES) != hipSuccess) { fprintf(stderr, "kernel_launch: hipFuncSetAttribute failed\n"); grid = -1; return; }
        if (hipOccupancyMaxActiveBlocksPerMultiprocessor(&per_cu, (const void*)mk_fwd, NWAVES * 64, LDS_BYTES) != hipSuccess || per_cu < 1)
            fprintf(stderr, "kernel_launch: note: occupancy query reports %d workgroups per CU\n", per_cu);
        (void)hipGetLastError();
        grid = cus;
        if (grid != 256) fprintf(stderr, "kernel_launch: note: %d CUs (tuned for 256)\n", grid);
    }
    if (grid < 0) return;
    if (hipMemsetAsync((char*)d_ws + WS_CTL, 0, CTL_ZERO_BYTES, stream) != hipSuccess) { fprintf(stderr, "kernel_launch: hipMemsetAsync failed\n"); return; }
    Args a{};
    for (int i = 0; i < 14; ++i) a.in[i] = (const float*)d_in[i];
    a.out = (float*)d_out; a.ws = (unsigned char*)d_ws;
    for (int li = 0; li < N_LAUNCHES; ++li) {
        a.ph_lo = (N_LAUNCHES == 1) ? 0 : li; a.ph_hi = (N_LAUNCHES == 1) ? N_PHASES : li + 1; a.li = li;
        hipLaunchKernelGGL(mk_fwd, dim3(grid), dim3(NWAVES * 64), LDS_BYTES, stream, a);
        const hipError_t le = hipPeekAtLastError();
        if (le != hipSuccess) { fprintf(stderr, "kernel_launch: launch %d failed: %s\n", li, hipGetErrorName(le)); break; }
    }
}
```

```cpp
#include <hip/hip_runtime.h>
#include <cstdio>
#include <cstdint>
namespace pg8 {
#define PG8_LAS __attribute__((address_space(3)))
typedef unsigned short bf16_t;
typedef short bf16x8 __attribute__((ext_vector_type(8)));
typedef float f32x4 __attribute__((ext_vector_type(4)));
typedef unsigned u32x4 __attribute__((ext_vector_type(4)));
constexpr int BM = 256, BK = 64, HALF = 128, HTB = HALF * BK * 2  , STAGE_BYTES = 8 * HTB, NXCD = 8, WGM = 8;

__host__ __device__ __forceinline__ int lds_byte(int r, int c) { const int st = (r >> 4) * 2 + (c >> 5), rr = r & 15, cc = c & 31, ob = rr * 64 + cc * 2; return st * 1024 + (ob ^ (((ob >> 9) & 1) << 5)); }
__host__ __device__ __forceinline__ void stage_rc(int b, int& R, int& C) { const int st = b / 1024, sb = b % 1024, swz = sb ^ (((sb >> 9) & 1) << 5); R = (st >> 1) * 16 + swz / 64; C = (st & 1) * 32 + (swz % 64) / 2; }
__host__ __device__ __forceinline__ int perm32(int rho) { const int n = rho >> 4, i = rho & 15; return 8 * (i >> 2) + 4 * n + (i & 3); }

struct Unit { int pm, pn; };
struct Gemm { const bf16_t* A; const bf16_t* Bt; int M, N, K; };

struct StaticOrder {
    int nM, nN, nwg, G, c;
    __host__ __device__ void init(int M, int N, int G_, int c_) { nM = M / BM; nN = N / BM; nwg = nM * nN; G = G_; c = c_; }
    __host__ __device__ bool next(int i, Unit& u) const {
        const long L = (long)i * G + c; if (L >= nwg) return false;
        int wgid = (int)L; { const int q = nwg / NXCD, r = nwg % NXCD, xcd = wgid % NXCD, off = wgid / NXCD; wgid = (xcd < r ? xcd * (q + 1) : r * (q + 1) + (xcd - r) * q) + off; }
        const int nig = WGM * nN, gid = wgid / nig, fm = gid * WGM, gsz = (nM - fm) < WGM ? (nM - fm) : WGM;
        u.pm = fm + ((wgid % nig) % gsz); u.pn = (wgid % nig) / gsz; return true;
    }
    __device__ __forceinline__ void a_ready(const Unit&) const {}
    __device__ __forceinline__ void done(const Unit&) const {}
};

__device__ __forceinline__ unsigned cvt_pk_bf16(float lo, float hi) { unsigned r; asm volatile("v_cvt_pk_bf16_f32 %0, %1, %2" : "=v"(r) : "v"(lo), "v"(hi)); return r; }

struct EpiBf16S {
    static constexpr bool PERM = true, AFTER_DRAIN = false;
    bf16_t* O; int ldc; int nscale; float scale0;
    __device__ __forceinline__ void operator()(const f32x4 (&acc)[2][2][4][2], const Unit& u, int wr, int wc, int fr, int fq) const {
        const int row0 = u.pm * BM + wr * 64 + fr, col0 = u.pn * BM + wc * 32 + 8 * fq;
        const float sc = (u.pn < nscale) ? scale0 : 1.f;
#pragma unroll
        for (int ai = 0; ai < 2; ++ai)
#pragma unroll
            for (int m = 0; m < 4; ++m) { bf16_t* rowp = O + (size_t)(row0 + ai * HALF + m * 16) * ldc + col0;
#pragma unroll
                for (int bj = 0; bj < 2; ++bj) { const f32x4 v0 = acc[ai][bj][m][0] * sc, v1 = acc[ai][bj][m][1] * sc;
                    u32x4 w; w.x = cvt_pk_bf16(v0[0], v0[1]); w.y = cvt_pk_bf16(v0[2], v0[3]); w.z = cvt_pk_bf16(v1[0], v1[1]); w.w = cvt_pk_bf16(v1[2], v1[3]);
                    *(u32x4*)(rowp + bj * HALF) = w; } }
    }
};
struct EpiQkvGate {
    static constexpr bool PERM = true, AFTER_DRAIN = false;
    bf16_t* QKV; bf16_t* G; float qscale;
    __device__ __forceinline__ void operator()(const f32x4 (&acc)[2][2][4][2], const Unit& u, int wr, int wc, int fr, int fq) const {
        const int row0 = u.pm * BM + wr * 64 + fr;
        const bool isg = u.pn >= 36;
        const int ldc = isg ? 1024 : 9216;
        const int col0 = (isg ? (u.pn - 36) : u.pn) * BM + wc * 32 + 8 * fq;
        bf16_t* base = isg ? G : QKV;
        const float sc = (!isg && (u.pn % 12) < 4) ? qscale : 1.f;
#pragma unroll
        for (int ai = 0; ai < 2; ++ai)
#pragma unroll
            for (int m = 0; m < 4; ++m) { bf16_t* rowp = base + (size_t)(row0 + ai * HALF + m * 16) * ldc + col0;
#pragma unroll
                for (int bj = 0; bj < 2; ++bj) { f32x4 v0 = acc[ai][bj][m][0] * sc, v1 = acc[ai][bj][m][1] * sc;
                    if (isg) {
#pragma unroll
                        for (int e = 0; e < 4; ++e) { v0[e] = v0[e] * __builtin_amdgcn_rcpf(1.f + __builtin_amdgcn_exp2f(-1.4426950408889634f * v0[e]));
                                                      v1[e] = v1[e] * __builtin_amdgcn_rcpf(1.f + __builtin_amdgcn_exp2f(-1.4426950408889634f * v1[e])); } }
                    u32x4 w; w.x = cvt_pk_bf16(v0[0], v0[1]); w.y = cvt_pk_bf16(v0[2], v0[3]); w.z = cvt_pk_bf16(v1[0], v1[1]); w.w = cvt_pk_bf16(v1[2], v1[3]);
                    *(u32x4*)(rowp + bj * HALF) = w; } }
    }
};
struct EpiResid {
    static constexpr bool PERM = false, AFTER_DRAIN = false;
    const float* base; float* out; int ldc; const float* gate;
    __device__ __forceinline__ void operator()(const f32x4 (&acc)[2][2][4][2], const Unit& u, int wr, int wc, int fr, int fq) const {
        const int row0 = u.pm * BM + wr * 64 + fr, col0 = u.pn * BM + wc * 32 + 4 * fq;
        const float* gp = gate + (size_t)(u.pm >> 3) * 3072 + col0;
        f32x4 gv[2][2];
#pragma unroll
        for (int bj = 0; bj < 2; ++bj)
#pragma unroll
            for (int n = 0; n < 2; ++n) gv[bj][n] = *(const f32x4*)(gp + bj * HALF + n * 16);
#pragma unroll
        for (int ai = 0; ai < 2; ++ai)
#pragma unroll
            for (int m = 0; m < 4; ++m) { const size_t off = (size_t)(row0 + ai * HALF + m * 16) * ldc + col0;
#pragma unroll
                for (int bj = 0; bj < 2; ++bj)
#pragma unroll
                    for (int n = 0; n < 2; ++n) { const f32x4 bs = *(const f32x4*)(base + off + bj * HALF + n * 16); *(f32x4*)(out + off + bj * HALF + n * 16) = bs + gv[bj][n] * acc[ai][bj][m][n]; }
                if (m & 1) asm volatile("" ::: "memory"); }
    }
};

template <class Epi, class Sched, bool ALIGN_EPI = false, bool SP2 = false>
__device__ __forceinline__ void gemm_phase(PG8_LAS unsigned char* lds, const Gemm g, const Sched& S, const Epi& E) {
    int tid_o = threadIdx.x; asm volatile("" : "+v"(tid_o));
    const int tid = tid_o, wid = __builtin_amdgcn_readfirstlane(tid >> 6), lane = tid & 63, wr = wid >> 2, wc = wid & 3, fr = lane & 15, fq = lane >> 4;
    const int K = g.K, nt = K / BK;
    unsigned voffA[2], voffB[2];
#pragma unroll
    for (int i = 0; i < 2; ++i) { int R, C; stage_rc(tid * 16 + i * 8192, R, C); const int Rb = Epi::PERM ? ((R & ~31) + perm32(R & 31)) : R;
        voffA[i] = (unsigned)(R * K + C) * 2u; voffB[i] = (unsigned)(Rb * K + C) * 2u; }
    const size_t kstep = (size_t)(BK * 2);
    const size_t hstep = (size_t)HALF * K * 2;
    const size_t tstep = 2 * hstep;
    const unsigned ldsw = (unsigned)wid * 1024u;
    const int aoff = lds_byte(wr * 64 + fr, fq * 8), boff = lds_byte(wc * 32 + fr, fq * 8);
#define PG8_SA(b, h) (((b) * 2 + (h)) * HTB)
#define PG8_SB(b, h) ((4 + (b) * 2 + (h)) * HTB)
#define PG8_STAGE(bufoff, gbase, voff) do { _Pragma("unroll") for (int _i = 0; _i < 2; ++_i) \
        __builtin_amdgcn_global_load_lds((const unsigned*)((const char*)(gbase) + (voff)[_i]), (PG8_LAS unsigned*)(lds + (bufoff) + ldsw + _i * 8192), 16, 0, 0); } while (0)
#define PG8_LDA(dst, b, h) do { _Pragma("unroll") for (int m = 0; m < 4; ++m) _Pragma("unroll") for (int k = 0; k < 2; ++k) dst[m][k] = *(const PG8_LAS bf16x8*)(lds + PG8_SA(b, h) + aoff + m * 2048 + k * 1024); } while (0)
#define PG8_LDB(dst, b, h) do { _Pragma("unroll") for (int n = 0; n < 2; ++n) _Pragma("unroll") for (int k = 0; k < 2; ++k) dst[n][k] = *(const PG8_LAS bf16x8*)(lds + PG8_SB(b, h) + boff + n * 2048 + k * 1024); } while (0)
#define PG8_MMA(ai, bj, At, Bt) do { __builtin_amdgcn_s_setprio(1); _Pragma("unroll") for (int m = 0; m < 4; ++m) _Pragma("unroll") for (int n = 0; n < 2; ++n) _Pragma("unroll") for (int k = 0; k < 2; ++k) \
        acc[ai][bj][m][n] = __builtin_amdgcn_mfma_f32_16x16x32_bf16(Bt[n][k], At[m][k], acc[ai][bj][m][n], 0, 0, 0); __builtin_amdgcn_s_setprio(0); } while (0)
#define PG8_WAIT_V(n) asm volatile("s_waitcnt vmcnt(" #n ")" ::: "memory")
#define PG8_WAIT_L(n) asm volatile("s_waitcnt lgkmcnt(" #n ")" ::: "memory")
#define PG8_BAR __builtin_amdgcn_s_barrier()
#define PG8_SCHED __builtin_amdgcn_sched_barrier(0)
    Unit cur, nxt; int ui = 0;
    if (!S.next(0, cur)) return;
    f32x4 acc[2][2][4][2];
#pragma unroll
    for (int a = 0; a < 2; ++a)
#pragma unroll
        for (int b = 0; b < 2; ++b)
#pragma unroll
            for (int m = 0; m < 4; ++m)
#pragma unroll
                for (int n = 0; n < 2; ++n) acc[a][b][m][n] = (f32x4){0.f, 0.f, 0.f, 0.f};
    bf16x8 At[4][2], B0[2][2], B1[2][2];
    const char* cA = (const char*)g.A + (size_t)cur.pm * tstep; const char* cB = (const char*)g.Bt + (size_t)cur.pn * tstep;
    S.a_ready(cur);
    if constexpr (SP2) {
        PG8_STAGE(PG8_SB(0, 0), cB, voffB); PG8_STAGE(PG8_SB(0, 1), cB + hstep, voffB); PG8_STAGE(PG8_SA(0, 0), cA, voffA); PG8_STAGE(PG8_SA(0, 1), cA + hstep, voffA);
        if (wr == 1) PG8_BAR;
        PG8_WAIT_V(2); PG8_BAR;
        PG8_STAGE(PG8_SB(1, 0), cB + kstep, voffB); PG8_STAGE(PG8_SA(1, 0), cA + kstep, voffA); PG8_STAGE(PG8_SB(1, 1), cB + hstep + kstep, voffB);
        PG8_WAIT_V(6); PG8_BAR;
    } else {
        PG8_STAGE(PG8_SB(0, 0), cB, voffB); PG8_STAGE(PG8_SA(0, 0), cA, voffA); PG8_STAGE(PG8_SB(0, 1), cB + hstep, voffB); PG8_STAGE(PG8_SA(0, 1), cA + hstep, voffA);
        if (wr == 1) PG8_BAR;
        PG8_WAIT_V(4); PG8_BAR;
        PG8_STAGE(PG8_SB(1, 0), cB + kstep, voffB); PG8_STAGE(PG8_SA(1, 0), cA + kstep, voffA); PG8_STAGE(PG8_SB(1, 1), cB + hstep + kstep, voffB);
        PG8_WAIT_V(6); PG8_BAR;
    }
    for (;;) {
        const bool has_next = S.next(ui + 1, nxt);
        const char* nA = has_next ? (const char*)g.A + (size_t)nxt.pm * tstep : cA; const char* nB = has_next ? (const char*)g.Bt + (size_t)nxt.pn * tstep : cB;
        for (int t = 0; t < nt; t += 2) {
            const bool last = (t == nt - 2);
            const char* a1 = cA + (size_t)(t + 1) * kstep;
            const char* a2 = last ? nA : cA + (size_t)(t + 2) * kstep; const char* b2 = last ? nB : cB + (size_t)(t + 2) * kstep;
            const char* a3 = a2 + kstep; const char* b3 = b2 + kstep;
            if (last && has_next) S.a_ready(nxt);
            if constexpr (SP2) {
            PG8_LDB(B0, 0, 0); PG8_LDB(B1, 0, 1); PG8_SCHED; PG8_LDA(At, 0, 0); PG8_STAGE(PG8_SA(1, 1), a1 + hstep, voffA);
            PG8_WAIT_V(8); PG8_WAIT_L(0); PG8_BAR; PG8_MMA(0, 0, At, B0); PG8_MMA(0, 1, At, B1); PG8_BAR; PG8_SCHED;
            PG8_LDA(At, 0, 1); PG8_STAGE(PG8_SB(0, 0), b2, voffB); PG8_STAGE(PG8_SB(0, 1), b2 + hstep, voffB); PG8_STAGE(PG8_SA(0, 0), a2, voffA);
            PG8_WAIT_V(8); PG8_WAIT_L(0); PG8_BAR; PG8_MMA(1, 0, At, B0); PG8_MMA(1, 1, At, B1); PG8_BAR; PG8_SCHED;
            PG8_LDB(B0, 1, 0); PG8_LDB(B1, 1, 1); PG8_SCHED; PG8_LDA(At, 1, 0); PG8_STAGE(PG8_SA(0, 1), a2 + hstep, voffA);
            PG8_WAIT_V(8); PG8_WAIT_L(0); PG8_BAR; PG8_MMA(0, 0, At, B0); PG8_MMA(0, 1, At, B1); PG8_BAR; PG8_SCHED;
            PG8_LDA(At, 1, 1); PG8_STAGE(PG8_SB(1, 0), b3, voffB); PG8_STAGE(PG8_SB(1, 1), b3 + hstep, voffB); PG8_STAGE(PG8_SA(1, 0), a3, voffA);
            PG8_WAIT_V(8); PG8_WAIT_L(0); PG8_BAR; PG8_MMA(1, 0, At, B0); PG8_MMA(1, 1, At, B1); PG8_BAR; PG8_SCHED;
            } else {
            PG8_LDB(B0, 0, 0); PG8_SCHED; PG8_LDA(At, 0, 0); PG8_STAGE(PG8_SA(1, 1), a1 + hstep, voffA);
            PG8_WAIT_L(8); PG8_BAR; PG8_WAIT_L(0); PG8_MMA(0, 0, At, B0); PG8_BAR; PG8_SCHED;
            PG8_LDB(B1, 0, 1); PG8_STAGE(PG8_SB(0, 0), b2, voffB);
            PG8_BAR; PG8_WAIT_L(0); PG8_MMA(0, 1, At, B1); PG8_BAR;
            PG8_LDA(At, 0, 1); PG8_STAGE(PG8_SA(0, 0), a2, voffA);
            PG8_BAR; PG8_WAIT_L(0); PG8_MMA(1, 0, At, B0); PG8_BAR; PG8_SCHED;
            PG8_STAGE(PG8_SB(0, 1), b2 + hstep, voffB);
            PG8_WAIT_V(6); PG8_BAR; PG8_MMA(1, 1, At, B1); PG8_BAR;
            PG8_LDB(B0, 1, 0); PG8_SCHED; PG8_LDA(At, 1, 0); PG8_STAGE(PG8_SA(0, 1), a2 + hstep, voffA);
            PG8_WAIT_L(8); PG8_BAR; PG8_WAIT_L(0); PG8_MMA(0, 0, At, B0); PG8_BAR; PG8_SCHED;
            PG8_LDB(B1, 1, 1); PG8_STAGE(PG8_SB(1, 0), b3, voffB);
            PG8_BAR; PG8_WAIT_L(0); PG8_MMA(0, 1, At, B1); PG8_BAR;
            PG8_LDA(At, 1, 1); PG8_STAGE(PG8_SA(1, 0), a3, voffA);
            PG8_BAR; PG8_WAIT_L(0); PG8_MMA(1, 0, At, B0); PG8_BAR; PG8_SCHED;
            PG8_STAGE(PG8_SB(1, 1), b3 + hstep, voffB);
            PG8_WAIT_V(6); PG8_BAR; PG8_MMA(1, 1, At, B1); PG8_BAR;
            }
        }
        if constexpr (ALIGN_EPI) { if (wr == 0) PG8_BAR; }
        if constexpr (!Epi::AFTER_DRAIN) { E(acc, cur, wr, wc, fr, fq); S.done(cur); }
        if (!has_next) break;
#pragma unroll
        for (int a = 0; a < 2; ++a)
#pragma unroll
            for (int b = 0; b < 2; ++b)
#pragma unroll
                for (int m = 0; m < 4; ++m)
#pragma unroll
                    for (int n = 0; n < 2; ++n) acc[a][b][m][n] = (f32x4){0.f, 0.f, 0.f, 0.f};
        cur = nxt; cA = nA; cB = nB; ++ui;
        if constexpr (ALIGN_EPI) { if (wr == 1) PG8_BAR; }
    }
    PG8_WAIT_V(0);
    if constexpr (!ALIGN_EPI) { if (wr == 0) PG8_BAR; }
    PG8_BAR;
    if constexpr (Epi::AFTER_DRAIN) { E.fused(acc, cur, wr, wc, fr, fq, lds, wid, lane); S.done(cur); }
#undef PG8_SA
#undef PG8_SB
#undef PG8_STAGE
#undef PG8_LDA
#undef PG8_LDB
#undef PG8_MMA
#undef PG8_WAIT_V
#undef PG8_WAIT_L
#undef PG8_BAR
#undef PG8_SCHED
}
}
#define GAS __attribute__((address_space(1)))
#define LAS __attribute__((address_space(3)))
typedef unsigned short bf16;
typedef unsigned v4u __attribute__((ext_vector_type(4)));
typedef float f32x4 __attribute__((ext_vector_type(4)));
typedef short bf16x8 __attribute__((ext_vector_type(8)));
typedef GAS unsigned gu32;
typedef GAS unsigned long long gu64;
#define RLX_AGENT __ATOMIC_RELAXED, __HIP_MEMORY_SCOPE_AGENT
#define LDS_WAIT() asm volatile("s_waitcnt lgkmcnt(0)" ::: "memory")
#define VM_WAIT() asm volatile("s_waitcnt vmcnt(0)" ::: "memory")
__device__ __forceinline__ unsigned long long rt() { return __builtin_amdgcn_s_memrealtime(); }
__device__ __forceinline__ unsigned f2bf(float f) { unsigned u = __builtin_bit_cast(unsigned, f); return (u + 0x7fffu + ((u >> 16) & 1u)) >> 16; }
__device__ __forceinline__ unsigned pk2(float lo, float hi) { return f2bf(lo) | (f2bf(hi) << 16); }

#define XB_TMO      128
#define XB_XCNT(j)  (256  + 64 * (j))
#define XB_XSUB(j)  (1280 + 64 * (j))
#define XB_XGEN(j)  (2304 + 64 * (j))
#define XB_TOP      3328
#define XB_TOPGEN   3392
#define XCD_BAR_WORDS 3456
#define XB_SPIN_CAP (1u << 18)

__device__ __forceinline__ unsigned xb_ld(unsigned* p)              { return __hip_atomic_load(p, __ATOMIC_RELAXED, __HIP_MEMORY_SCOPE_AGENT); }
__device__ __forceinline__ unsigned xb_add(unsigned* p, unsigned v) { return __hip_atomic_fetch_add(p, v, __ATOMIC_RELAXED, __HIP_MEMORY_SCOPE_AGENT); }
__device__ __forceinline__ unsigned xb_xcc_id() { return (unsigned)__builtin_amdgcn_s_getreg((3 << 11) | 20) & 0xFu; }
#define XB_SPIN(cond, bar) do { unsigned _sp = 0; while (cond) { __builtin_amdgcn_s_sleep(1); \
    if ((++_sp & 255u) == 0u) { if (xb_ld(&(bar)[XB_TMO])) break; if (_sp > XB_SPIN_CAP) { atomicAdd(&(bar)[XB_TMO], 1u); break; } } } } while (0)

struct XcdBarrier {
    unsigned* bar; unsigned x;
    volatile LAS unsigned* st;
};

__device__ __forceinline__ XcdBarrier xcd_barrier_post(unsigned* bar, volatile LAS unsigned* st) {
    XcdBarrier b; b.bar = bar; b.x = xb_xcc_id(); b.st = st;
    if (threadIdx.x == 0) (void)xb_add(&bar[XB_XCNT(b.x)], 1u);
    return b;
}
__device__ __forceinline__ void xcd_barrier_complete(unsigned* bar, unsigned x, unsigned& nloc, unsigned& nx) {
    const unsigned G = gridDim.x * gridDim.y * gridDim.z;
    unsigned sum, cnt, mine, sp = 0u;
    for (;;) {
        sum = 0u; cnt = 0u; mine = 0u;
#pragma unroll
        for (unsigned j = 0; j < 16; ++j) { const unsigned c = xb_ld(&bar[XB_XCNT(j)]); sum += c; cnt += (c > 0u) ? 1u : 0u; mine = (j == x) ? c : mine; }
        if (sum == G) break;
        __builtin_amdgcn_s_sleep(1);
        if ((++sp & 255u) == 0u) { if (xb_ld(&bar[XB_TMO])) break; if (sp > XB_SPIN_CAP) { atomicAdd(&bar[XB_TMO], 1u); break; } }
    }
    nloc = mine > 0u ? mine : 1u; nx = cnt > 0u ? cnt : 1u;
}

__device__ __forceinline__ void xcd_barrier(const XcdBarrier& b) {
    asm volatile("s_waitcnt vmcnt(0)" ::: "memory");
    __syncthreads();
    if (threadIdx.x == 0) {
        unsigned* bar = b.bar;
        __builtin_amdgcn_s_waitcnt(0);
        unsigned nloc = b.st[0], nx = b.st[1];
        if (nloc == 0u) { xcd_barrier_complete(bar, b.x, nloc, nx); b.st[0] = nloc; b.st[1] = nx; }
        const unsigned old = xb_add(&bar[XB_XSUB(b.x)], 1u);
        const unsigned gen = old / nloc;
        if (old + 1u == (gen + 1u) * nloc) {
            __builtin_amdgcn_fence(__ATOMIC_RELEASE, "agent");
            asm volatile("s_waitcnt vmcnt(0)" ::: "memory");
            const unsigned og = xb_add(&bar[XB_TOP], 1u);
            const unsigned tg = og / nx;
            if (og + 1u == (tg + 1u) * nx) xb_add(&bar[XB_TOPGEN], 1u);
            else XB_SPIN(xb_ld(&bar[XB_TOPGEN]) == tg, bar);
            __builtin_amdgcn_fence(__ATOMIC_ACQUIRE, "agent");
            xb_add(&bar[XB_XGEN(b.x)], 1u);
            asm volatile("s_waitcnt vmcnt(0)" ::: "memory");
        } else {
            XB_SPIN(xb_ld(&bar[XB_XGEN(b.x)]) == gen, bar);
            __builtin_amdgcn_fence(__ATOMIC_ACQUIRE, "agent");
            asm volatile("s_waitcnt vmcnt(0)" ::: "memory");
        }
    }
    __syncthreads();
}

constexpr int NWAVES = 8;
constexpr int BATCH = 16, SEQ = 2048, D = 1024, M = BATCH * SEQ;
constexpr int GLA_IN = 3088, N0 = 3072;
constexpr int DSW_IN = 10240, NQKV1 = 9216;
constexpr int NPART = 4, MP = M / NPART;
constexpr float EPS = 1e-6f, LOG2E = 1.4426950408889634f;
constexpr float QSCALE0 = 0.08838834764831845f;
constexpr float QSCALE1 = 0.125f * LOG2E;

constexpr size_t MiB = 1u << 20;
constexpr size_t WS_CTL = 0, CTL_ZERO_BYTES = 1 * MiB;
constexpr size_t WS_MOD = 1 * MiB;
constexpr size_t WS_BIAS = 1 * MiB + 512 * 1024;
constexpr size_t WS_WT0 = 2 * MiB, WS_WT1 = 8 * MiB, WS_WTO0 = 28 * MiB, WS_WTO1 = 30 * MiB;
constexpr size_t WS_XN = 32 * MiB;
constexpr size_t WS_XN2 = 96 * MiB;
constexpr size_t WS_BIG = 160 * MiB;
constexpr size_t WS_QKVR = WS_BIG;
constexpr size_t WS_AM = WS_BIG + 192 * MiB;
constexpr size_t WS_QS = WS_BIG + 208 * MiB;
constexpr size_t WS_KST = WS_BIG + 240 * MiB;
constexpr size_t WS_DEC = WS_BIG + 272 * MiB;
constexpr size_t WS_SSQ = WS_BIG + 280 * MiB;
constexpr size_t WS_GLR = WS_BIG + 276 * MiB;
constexpr size_t WS_QKV1 = WS_BIG;
constexpr size_t WS_OG = WS_BIG + 144 * MiB;
constexpr size_t WS_LSE = WS_BIG + 192 * MiB;
constexpr size_t WS_GATE = WS_BIG + 196 * MiB;
constexpr size_t WS_END = WS_BIG + 288 * MiB;
constexpr int CW_BAR = 4096;

constexpr int RING_OFF = 0, RING_BYTES = 131072;
constexpr int LDSCTL_OFF = 139264, MISC_OFF = LDSCTL_OFF + 320;
constexpr int LDS_BYTES = 147456;

typedef short s16x4 __attribute__((ext_vector_type(4)));
typedef float f32x16 __attribute__((ext_vector_type(16)));
template <class T> __device__ __forceinline__ T* as_global(T* p) { return (T*)(GAS T*)p; }
__device__ __forceinline__ float bf2f(bf16 b) { return __uint_as_float((unsigned)b << 16); }
__device__ __forceinline__ float wave_sum(float v) {
#pragma unroll
    for (int o = 1; o < 64; o <<= 1) v += __shfl_xor(v, o);
    return v;
}
__device__ __forceinline__ float wave_max(float v) {
#pragma unroll
    for (int o = 1; o < 64; o <<= 1) v = fmaxf(v, __shfl_xor(v, o));
    return v;
}
__device__ __forceinline__ float silu_f(float v) { return v / (1.f + __expf(-v)); }

__device__ __forceinline__ void transpose_item(const float* W, int ldw, int scol0, int K, bf16* WT, int drow0, LAS float* scr, int kb, int nb, int lane) {
    const int k0 = 64 * kb, n0 = 32 * nb;
#pragma unroll 8
    for (int i = 0; i < 32; ++i) { const int kk = 2 * i + (lane >> 5); scr[kk * 33 + (lane & 31)] = W[(size_t)(k0 + kk) * ldw + scol0 + n0 + (lane & 31)]; }
    LDS_WAIT(); asm volatile("" ::: "memory");
    const int c = lane & 7;
#pragma unroll
    for (int j = 0; j < 4; ++j) { const int n = (lane >> 3) + 8 * j; const LAS float* s = scr + (8 * c) * 33 + n;
        v4u o; o.x = pk2(s[0 * 33], s[1 * 33]); o.y = pk2(s[2 * 33], s[3 * 33]); o.z = pk2(s[4 * 33], s[5 * 33]); o.w = pk2(s[6 * 33], s[7 * 33]);
        *(GAS v4u*)(WT + (size_t)(drow0 + n0 + n) * K + k0 + 8 * c) = o; }
    LDS_WAIT(); asm volatile("" ::: "memory");
}
__device__ __forceinline__ int t5_bucket(int n) {
    if (n < 16) return n;
    int b = 16;
    b += (n >= 22); b += (n >= 30); b += (n >= 40); b += (n >= 54); b += (n >= 73); b += (n >= 99); b += (n >= 134); b += (n >= 182);
    b += (n >= 246); b += (n >= 332); b += (n >= 450); b += (n >= 609); b += (n >= 825); b += (n >= 1117); b += (n >= 1513);
    return b;
}

__device__ __forceinline__ float reduce16(const float (&a)[16], int lane, int& col) {
    float b8[8], b4[4], b2[2], b1;
    const bool h5 = (lane & 32) != 0, h4 = (lane & 16) != 0, h3 = (lane & 8) != 0, h2 = (lane & 4) != 0;
#pragma unroll
    for (int c = 0; c < 8; ++c) { const float keep = h5 ? a[c + 8] : a[c], send = h5 ? a[c] : a[c + 8]; b8[c] = keep + __shfl_xor(send, 32); }
#pragma unroll
    for (int c = 0; c < 4; ++c) { const float keep = h4 ? b8[c + 4] : b8[c], send = h4 ? b8[c] : b8[c + 4]; b4[c] = keep + __shfl_xor(send, 16); }
#pragma unroll
    for (int c = 0; c < 2; ++c) { const float keep = h3 ? b4[c + 2] : b4[c], send = h3 ? b4[c] : b4[c + 2]; b2[c] = keep + __shfl_xor(send, 8); }
    { const float keep = h2 ? b2[1] : b2[0], send = h2 ? b2[0] : b2[1]; b1 = keep + __shfl_xor(send, 4); }
    b1 += __shfl_xor(b1, 2); b1 += __shfl_xor(b1, 1);
    col = (h5 ? 8 : 0) + (h4 ? 4 : 0) + (h3 ? 2 : 0) + (h2 ? 1 : 0);
    return b1;
}

struct Args { const float* in[14]; float* out; unsigned char* ws; int ph_lo, ph_hi, li, pad; };
constexpr int N_PHASES = 19;
#ifndef MK_N_LAUNCHES
#define MK_N_LAUNCHES 1
#endif
constexpr int N_LAUNCHES = MK_N_LAUNCHES;

__global__ void __launch_bounds__(NWAVES * 64, 2) mk_fwd(Args args) {
    extern __shared__ __attribute__((aligned(16))) unsigned char lds_raw[];
    LAS unsigned char* lds = (LAS unsigned char*)lds_raw;
    volatile LAS unsigned* MISC = (volatile LAS unsigned*)(lds + MISC_OFF);
    const int G = gridDim.x; const int bx = blockIdx.x; const int vcu0 = (G % 8 == 0) ? (bx % 8) * (G / 8) + bx / 8 : bx;
    const int NGW = G * NWAVES;
#define KA_LOAD() \
    int tid = threadIdx.x; asm volatile("" : "+v"(tid)); const int lane = tid & 63, wave = __builtin_amdgcn_readfirstlane(tid >> 6); \
    int vcu = vcu0; asm volatile("" : "+s"(vcu)); const int gw = vcu * NWAVES + wave; (void)lane; (void)gw; \
    const __attribute__((address_space(4))) Args* ka_ = (const __attribute__((address_space(4))) Args*)__builtin_amdgcn_kernarg_segment_ptr(); asm volatile("" : "+s"(ka_)); \
    unsigned char* ws = as_global(ka_->ws); float* out = as_global(ka_->out); (void)ws; (void)out; \
    const float* x = as_global(ka_->in[0]); const float* cvec = as_global(ka_->in[1]); const float* ada_w = as_global(ka_->in[2]); const float* ada_b = as_global(ka_->in[3]); const float* norm_g = as_global(ka_->in[4]); \
    const float* gla_w_in = as_global(ka_->in[5]); const float* gla_w_alpha = as_global(ka_->in[6]); const float* gla_b_alpha = as_global(ka_->in[7]); const float* gla_norm_g = as_global(ka_->in[8]); \
    const float* gla_w_out = as_global(ka_->in[9]); const float* dsw_w_in = as_global(ka_->in[10]); const float* dsw_w_out = as_global(ka_->in[11]); const float* rel_bias = as_global(ka_->in[12]); const float* final_g = as_global(ka_->in[13]); \
    (void)x; (void)cvec; (void)ada_w; (void)ada_b; (void)norm_g; (void)gla_w_in; (void)gla_w_alpha; (void)gla_b_alpha; (void)gla_norm_g; (void)gla_w_out; (void)dsw_w_in; (void)dsw_w_out; (void)rel_bias; (void)final_g; \
    float* MOD = (float*)(ws + WS_MOD); float* BIAS = (float*)(ws + WS_BIAS); (void)MOD; (void)BIAS; \
    bf16* WT0 = (bf16*)(ws + WS_WT0); bf16* WT1 = (bf16*)(ws + WS_WT1); bf16* WTO0 = (bf16*)(ws + WS_WTO0); bf16* WTO1 = (bf16*)(ws + WS_WTO1); (void)WT0; (void)WT1; (void)WTO0; (void)WTO1; \
    bf16* XN = (bf16*)(ws + WS_XN); bf16* XN2 = (bf16*)(ws + WS_XN2); bf16* QKVR = (bf16*)(ws + WS_QKVR); (void)XN; (void)XN2; (void)QKVR; \
    float* SSQ = (float*)(ws + WS_SSQ); float* GLR = (float*)(ws + WS_GLR); (void)SSQ; (void)GLR; \
    bf16* QKV1 = (bf16*)(ws + WS_QKV1); bf16* OG = (bf16*)(ws + WS_OG); float* LSE = (float*)(ws + WS_LSE); bf16* GATE = (bf16*)(ws + WS_GATE); (void)QKV1; (void)OG; (void)LSE; (void)GATE;
    gu32* ctl = (gu32*)(args.ws + WS_CTL);

    for (int u = threadIdx.x; u < (LDS_BYTES - LDSCTL_OFF) / 4; u += NWAVES * 64) ((LAS unsigned*)(lds + LDSCTL_OFF))[u] = 0u;
    __syncthreads();
    XcdBarrier bar; bar.bar = (unsigned*)(ctl + CW_BAR); bar.x = 0; bar.st = nullptr;
    if (N_LAUNCHES == 1) bar = xcd_barrier_post((unsigned*)(ctl + CW_BAR), MISC + 8);
#define GRID_BAR() do { if (N_LAUNCHES == 1) xcd_barrier(bar); } while (0)
    const int lo = args.ph_lo, hi = args.ph_hi;
#define IN(k) (lo <= (k) && (k) < hi)
#define BOTH(k) (IN(k) && IN((k) + 1))

    if (IN(0)) { KA_LOAD();
        {
            LAS float* scr = (LAS float*)(lds + RING_OFF + wave * 16384);
            for (int it = gw; it < 7680; it += NGW) {
                int r = it;
                if (r < 1024) { transpose_item(gla_w_in, GLA_IN, 0, D, WT0, 0, scr, r / 64, r % 64, lane); continue; } r -= 1024;
                if (r < 512) { transpose_item(gla_w_in, GLA_IN, 2064, D, WT0, 2048, scr, r / 32, r % 32, lane); continue; } r -= 512;
                if (r < 5120) { transpose_item(dsw_w_in, DSW_IN, 0, D, WT1, 0, scr, r / 320, r % 320, lane); continue; } r -= 5120;
                if (r < 512) { transpose_item(gla_w_out, D, 0, D, WTO0, 0, scr, r / 32, r % 32, lane); continue; } r -= 512;
                transpose_item(dsw_w_out, D, 0, D, WTO1, 0, scr, r / 32, r % 32, lane);
            }
        }
        __syncthreads();
        if (vcu < 96) {
            const int layer = vcu / 48, cb = vcu % 48, col = cb * 64 + lane;
            LAS float* sc = (LAS float*)lds;
            LAS float* red = (LAS float*)(lds + 65536);
            for (int i = 0; i < 32; ++i) { const int idx = i * 512 + tid, b = idx >> 10, k = idx & 1023; sc[k * 16 + b] = silu_f(cvec[idx]); }
            __syncthreads();
            float acc[16];
#pragma unroll
            for (int b = 0; b < 16; ++b) acc[b] = 0.f;
            const float* wp = ada_w + (size_t)layer * D * 3072 + (size_t)(wave * 128) * 3072 + col;
#pragma unroll 4
            for (int kk = 0; kk < 128; ++kk) { const float w = wp[(size_t)kk * 3072]; const LAS f32x4* s4 = (const LAS f32x4*)(sc + (wave * 128 + kk) * 16);
#pragma unroll
                for (int q = 0; q < 4; ++q) { const f32x4 s = s4[q]; acc[4 * q + 0] += s[0] * w; acc[4 * q + 1] += s[1] * w; acc[4 * q + 2] += s[2] * w; acc[4 * q + 3] += s[3] * w; } }
#pragma unroll
            for (int b = 0; b < 16; ++b) red[(wave * 16 + b) * 64 + lane] = acc[b];
            __syncthreads();
            for (int r = 0; r < 2; ++r) { const int idx = tid + r * 512, b = idx >> 6, cl = idx & 63; float s = 0.f;
#pragma unroll
                for (int w = 0; w < 8; ++w) s += red[(w * 16 + b) * 64 + cl];
                MOD[(size_t)(layer * 16 + b) * 3072 + cb * 64 + cl] = s + ada_b[layer * 3072 + cb * 64 + cl]; }
            __syncthreads();
        }
        if (vcu == G - 1) {
            for (int idx = tid; idx < 3 * 16 * 132; idx += NWAVES * 64) { const int g = idx / (16 * 132), h = (idx / 132) % 16, s = idx % 132; const int dil = g == 0 ? 1 : (g == 1 ? 4 : 16);
                BIAS[idx] = (s <= 128) ? rel_bias[t5_bucket(s * dil) * 16 + h] * LOG2E : 0.f; }
        }
        if (BOTH(0)) GRID_BAR();
    }

#define PRENORM(Xsrc, layer, WITH_GLR) do { \
        LAS float* wlr = (LAS float*)lds; \
        if (WITH_GLR) { for (int idx = tid; idx < 16384; idx += NWAVES * 64) { const int k = idx >> 4, c = idx & 15; wlr[c * 1028 + k] = gla_w_in[(size_t)k * GLA_IN + 2048 + c]; } __syncthreads(); } \
        const int b_ = gw >> 7; const float* mod_ = MOD + (size_t)((layer) * 16 + b_) * 3072; const float* gv_ = norm_g + (layer) * D; \
        f32x4 gs[4], sh[4]; \
        _Pragma("unroll") for (int j = 0; j < 4; ++j) { const int col = 256 * j + 4 * lane; const f32x4 g4 = *(const f32x4*)(gv_ + col), sc4 = *(const f32x4*)(mod_ + 1024 + col); sh[j] = *(const f32x4*)(mod_ + col); gs[j] = g4 * (1.f + sc4); } \
        for (int r = 0; r < 16; ++r) { asm volatile("" ::: "memory"); const size_t row = (size_t)gw * 16 + r; const float* xr = (Xsrc) + row * D; \
            f32x4 v[4]; float ss = 0.f; \
            _Pragma("unroll") for (int j = 0; j < 4; ++j) { v[j] = *(const f32x4*)(xr + 256 * j + 4 * lane); ss += (v[j][0] * v[j][0] + v[j][1] * v[j][1]) + (v[j][2] * v[j][2] + v[j][3] * v[j][3]); } \
            const float rstd = 1.0f / sqrtf(wave_sum(ss) * (1.f / D) + EPS); \
            _Pragma("unroll") for (int j = 0; j < 4; ++j) { v[j] = v[j] * rstd * gs[j] + sh[j]; \
                *(unsigned long long*)(XN + row * D + 256 * j + 4 * lane) = (unsigned long long)pk2(v[j][0], v[j][1]) | ((unsigned long long)pk2(v[j][2], v[j][3]) << 32); } \
            if (WITH_GLR) { float acc[16]; \
                _Pragma("unroll") for (int c = 0; c < 16; ++c) { float a = 0.f; \
                    _Pragma("unroll") for (int j = 0; j < 4; ++j) { const f32x4 w4 = *(const LAS f32x4*)(wlr + c * 1028 + 256 * j + 4 * lane); a += (v[j][0] * w4[0] + v[j][1] * w4[1]) + (v[j][2] * w4[2] + v[j][3] * w4[3]); } \
                    acc[c] = a; } \
                int col_; const float sres = reduce16(acc, lane, col_); if ((lane & 3) == 0) GLR[row * 16 + col_] = sres; } \
        } } while (0)

    if (IN(1)) { KA_LOAD(); PRENORM(x, 0, true); if (BOTH(1)) GRID_BAR(); }

    if (IN(2)) { KA_LOAD();
        pg8::Gemm g{XN, WT0, M, N0, D}; pg8::StaticOrder S; S.init(M, N0, G, bx);
        pg8::EpiBf16S E{QKVR, N0, 2, QSCALE0};
        pg8::gemm_phase<pg8::EpiBf16S, pg8::StaticOrder, true, true>(lds + RING_OFF, g, S, E);
        if (BOTH(2)) GRID_BAR();
    }

    if (IN(3)) { KA_LOAD();
        bf16* AM = (bf16*)(ws + WS_AM); bf16* QS = (bf16*)(ws + WS_QS); bf16* KST = (bf16*)(ws + WS_KST); float* DEC = (float*)(ws + WS_DEC);
        LAS unsigned short* qt = (LAS unsigned short*)lds;
        LAS unsigned short* kt = qt + 64 * 136;
        LAS float* tot = (LAS float*)(lds + 2 * 64 * 272);
        LAS float* fst = tot + 512;
        const int d = tid & 127, seg = tid >> 7, fr = lane & 15, kq = lane >> 4;
        const int bh = (vcu * 8) >> 5, h = bh & 3, b = bh >> 2;
        float wa[16];
#pragma unroll
        for (int i = 0; i < 16; ++i) wa[i] = gla_w_alpha[i * 512 + h * 128 + d];
        const float ba = gla_b_alpha[h * 128 + d];
        for (int it = 0; it < 8; ++it) {
            const int item = vcu * 8 + it, n = item & 31;
            const size_t row0 = (size_t)b * SEQ + n * 64;
            float bc[16]; float run = 0.f;
#pragma unroll
            for (int u = 0; u < 16; ++u) { const float* gl = GLR + (row0 + 16 * seg + u) * 16; float z = ba;
#pragma unroll
                for (int q4 = 0; q4 < 4; ++q4) { const f32x4 g4 = *(const f32x4*)(gl + 4 * q4); z += g4[0] * wa[4 * q4] + g4[1] * wa[4 * q4 + 1] + g4[2] * wa[4 * q4 + 2] + g4[3] * wa[4 * q4 + 3]; }
                const float ls = fminf(z, 0.f) - __logf(1.f + __expf(-fabsf(z)));
                run += ls * (1.f / 16.f); bc[u] = run; }
            tot[seg * 128 + d] = run; fst[seg * 128 + d] = bc[0];
            __syncthreads();
            const float t0 = tot[d], t1 = tot[128 + d], t2 = tot[256 + d], t3 = tot[384 + d];
            const float off = (seg > 0 ? t0 : 0.f) + (seg > 1 ? t1 : 0.f) + (seg > 2 ? t2 : 0.f);
            const float blast = (t0 + t1) + (t2 + t3), mid = (t0 + t1) + fst[256 + d];
            unsigned short ksv[16];
#pragma unroll
            for (int u = 0; u < 16; ++u) { const int t = 16 * seg + u; const float bb = bc[u] + off;
                const float q = bf2f(QKVR[(row0 + t) * N0 + h * 128 + d]), k = bf2f(QKVR[(row0 + t) * N0 + 512 + h * 128 + d]);
                const float e1 = __expf(bb - mid), e2 = __expf(mid - bb);
                qt[t * 136 + d] = (unsigned short)f2bf(q * e1); kt[t * 136 + d] = (unsigned short)f2bf(k * e2);
                const int d32 = d & 31;
                QS[(row0 + t) * 512 + h * 128 + (d & ~31) + 8 * ((d32 & 15) >> 2) + (d32 & 3) + 4 * (d32 >> 4)] = (bf16)f2bf(q * __expf(bb));
                ksv[u] = (unsigned short)f2bf(k * __expf(blast - bb)); }
#pragma unroll
            for (int gq = 0; gq < 4; ++gq)
                *(unsigned long long*)(KST + ((size_t)item * 128 + d) * 64 + 32 * (seg >> 1) + 8 * gq + 4 * (seg & 1)) =
                    (unsigned long long)ksv[4 * gq] | ((unsigned long long)ksv[4 * gq + 1] << 16) | ((unsigned long long)ksv[4 * gq + 2] << 32) | ((unsigned long long)ksv[4 * gq + 3] << 48);
            if (seg == 0) DEC[(size_t)item * 128 + d] = __expf(blast);
            __syncthreads();
            { const int ti = wave >> 1;
#pragma unroll
              for (int jj = 0; jj < 2; ++jj) { const int tj = 2 * (wave & 1) + jj; f32x4 acc = (f32x4){0.f, 0.f, 0.f, 0.f};
                if (tj <= ti) {
#pragma unroll
                    for (int ks = 0; ks < 4; ++ks) { const bf16x8 af = *(const LAS bf16x8*)(kt + (16 * tj + fr) * 136 + 32 * ks + 8 * kq), bfv = *(const LAS bf16x8*)(qt + (16 * ti + fr) * 136 + 32 * ks + 8 * kq);
                        acc = __builtin_amdgcn_mfma_f32_16x16x32_bf16(af, bfv, acc, 0, 0, 0); } }
                const int i = 16 * ti + fr, j0 = 16 * tj + 4 * kq;
                unsigned short w4[4];
#pragma unroll
                for (int r = 0; r < 4; ++r) w4[r] = (j0 + r <= i) ? (unsigned short)f2bf(acc[r]) : (unsigned short)0;
                *(unsigned long long*)(AM + ((size_t)item * 64 + i) * 64 + 32 * (tj >> 1) + 8 * kq + 4 * (tj & 1)) =
                    (unsigned long long)w4[0] | ((unsigned long long)w4[1] << 16) | ((unsigned long long)w4[2] << 32) | ((unsigned long long)w4[3] << 48); } }
        }
        if (BOTH(3)) GRID_BAR();
    }

    if (IN(4)) { KA_LOAD();
        const bf16* AM = (const bf16*)(ws + WS_AM); const bf16* QS = (const bf16*)(ws + WS_QS); const bf16* KST = (const bf16*)(ws + WS_KST); const float* DEC = (const float*)(ws + WS_DEC);
        bf16* O = XN;
        constexpr int SC_AM = 0, SC_QS = 9216, SC_KS = 9216 + 17408, SC_V = SC_KS + 18432, SC_DC = SC_V + 9216, SC_BUF = SC_DC + 512;
        const int item = vcu, b = item >> 4, h = (item >> 2) & 3, dvs = item & 3, bh = b * 4 + h;
        const int fr = lane & 15, kq = lane >> 4;
#define SCAN_LOAD(n_, t0_, NT_) do { const int n__ = (n_); LAS unsigned char* B_ = lds + (n__ & 1) * SC_BUF; const size_t ci_ = (size_t)bh * 32 + n__, r0_ = (size_t)b * SEQ + n__ * 64; \
            for (int pid = tid - (t0_); pid < 512; pid += (NT_)) { const int r_ = pid >> 3, c_ = pid & 7; \
                *(LAS v4u*)(B_ + SC_AM + r_ * 144 + c_ * 16) = *(const v4u*)(AM + (ci_ * 64 + r_) * 64 + c_ * 8); \
                *(LAS v4u*)(B_ + SC_V + r_ * 144 + c_ * 16) = *(const v4u*)(QKVR + (r0_ + r_) * N0 + 1024 + h * 256 + dvs * 64 + c_ * 8); } \
            for (int pid = tid - (t0_); pid < 1024; pid += (NT_)) { const int r_ = pid >> 4, c_ = pid & 15; \
                *(LAS v4u*)(B_ + SC_QS + r_ * 272 + c_ * 16) = *(const v4u*)(QS + (r0_ + r_) * 512 + h * 128 + c_ * 8); } \
            for (int pid = tid - (t0_); pid < 1024; pid += (NT_)) { const int r_ = pid >> 3, c_ = pid & 7; \
                *(LAS v4u*)(B_ + SC_KS + r_ * 144 + c_ * 16) = *(const v4u*)(KST + (ci_ * 128 + r_) * 64 + c_ * 8); } \
            if (tid - (t0_) < 32) *(LAS v4u*)(B_ + SC_DC + (tid - (t0_)) * 16) = *(const v4u*)(DEC + ci_ * 128 + (tid - (t0_)) * 4); } while (0)
        SCAN_LOAD(0, 0, 512);
        __syncthreads();
        f32x4 S[8];
#pragma unroll
        for (int T = 0; T < 8; ++T) S[T] = (f32x4){0.f, 0.f, 0.f, 0.f};
        for (int n = 0; n < 32; ++n) {
            if (wave >= 4) { if (n + 1 < 32) SCAN_LOAD(n + 1, 256, 256); }
            else {
                const LAS unsigned char* B_ = lds + (n & 1) * SC_BUF; const size_t row0 = (size_t)b * SEQ + n * 64;
                bf16x8 vf[2];
#pragma unroll
                for (int ks = 0; ks < 2; ++ks) { const LAS unsigned char* vp = B_ + SC_V + (32 * ks + 4 * kq + (fr >> 2)) * 144 + (16 * wave + 4 * (fr & 3)) * 2;
                    s16x4 lo, hi;
                    asm volatile("ds_read_b64_tr_b16 %0, %1" : "=v"(lo) : "v"((unsigned)(uintptr_t)vp) : "memory");
                    asm volatile("ds_read_b64_tr_b16 %0, %1 offset:2304" : "=v"(hi) : "v"((unsigned)(uintptr_t)vp) : "memory");
                    asm volatile("s_waitcnt lgkmcnt(0)" : "+v"(lo), "+v"(hi) :: "memory");
                    vf[ks] = (bf16x8){lo[0], lo[1], lo[2], lo[3], hi[0], hi[1], hi[2], hi[3]}; }
                bf16x8 sb[4];
#pragma unroll
                for (int kd = 0; kd < 4; ++kd) { const f32x4 s0 = S[2 * kd], s1 = S[2 * kd + 1]; v4u w; w.x = pk2(s0[0], s0[1]); w.y = pk2(s0[2], s0[3]); w.z = pk2(s1[0], s1[1]); w.w = pk2(s1[2], s1[3]); sb[kd] = __builtin_bit_cast(bf16x8, w); }
#pragma unroll
                for (int tb = 0; tb < 4; ++tb) { f32x4 acc = (f32x4){0.f, 0.f, 0.f, 0.f};
#pragma unroll
                    for (int ks = 0; ks < 2; ++ks) if (ks <= (tb >> 1)) { const bf16x8 af = *(const LAS bf16x8*)(B_ + SC_AM + (16 * tb + fr) * 144 + (32 * ks + 8 * kq) * 2); acc = __builtin_amdgcn_mfma_f32_16x16x32_bf16(af, vf[ks], acc, 0, 0, 0); }
#pragma unroll
                    for (int kd = 0; kd < 4; ++kd) { const bf16x8 af = *(const LAS bf16x8*)(B_ + SC_QS + (16 * tb + fr) * 272 + (32 * kd + 8 * kq) * 2); acc = __builtin_amdgcn_mfma_f32_16x16x32_bf16(af, sb[kd], acc, 0, 0, 0); }
#pragma unroll
                    for (int r = 0; r < 4; ++r) { const size_t row = row0 + 16 * tb + 4 * kq + r; O[row * D + h * 256 + dvs * 64 + 16 * wave + fr] = (bf16)f2bf(acc[r]);
                        float ss = acc[r] * acc[r]; ss += __shfl_xor(ss, 1); ss += __shfl_xor(ss, 2); ss += __shfl_xor(ss, 4); ss += __shfl_xor(ss, 8);
                        if (fr == 0) SSQ[row * 64 + h * 16 + dvs * 4 + wave] = ss; } }
#pragma unroll
                for (int T = 0; T < 8; ++T) { const f32x4 dc = *(const LAS f32x4*)(B_ + SC_DC + (16 * T + 4 * kq) * 4); S[T] = S[T] * dc;
#pragma unroll
                    for (int ks = 0; ks < 2; ++ks) { const bf16x8 af = *(const LAS bf16x8*)(B_ + SC_KS + (16 * T + fr) * 144 + (32 * ks + 8 * kq) * 2); S[T] = __builtin_amdgcn_mfma_f32_16x16x32_bf16(af, vf[ks], S[T], 0, 0, 0); } }
            }
            __syncthreads();
        }
#undef SCAN_LOAD
        if (BOTH(4)) GRID_BAR();
    }

    if (IN(5)) { KA_LOAD();
        const bf16* O = XN;
        const f32x4 g4 = *(const f32x4*)(gla_norm_g + 4 * lane);
        for (int r = 0; r < 16; ++r) { const size_t row = (size_t)gw * 16 + r;
#pragma unroll
            for (int j = 0; j < 4; ++j) { const int col = 256 * j + 4 * lane; float sum = 0.f;
#pragma unroll
                for (int q4 = 0; q4 < 4; ++q4) { const f32x4 s4 = *(const f32x4*)(SSQ + row * 64 + 16 * j + 4 * q4); sum += (s4[0] + s4[1]) + (s4[2] + s4[3]); }
                const float rstd = 1.0f / sqrtf(sum * (1.f / 256.f) + EPS);
                const unsigned long long ob = *(const unsigned long long*)(O + row * D + col), rb = *(const unsigned long long*)(QKVR + row * N0 + 2048 + col);
                float o[4], rr[4];
#pragma unroll
                for (int i = 0; i < 4; ++i) { o[i] = bf2f((bf16)(ob >> (16 * i))); rr[i] = bf2f((bf16)(rb >> (16 * i))); o[i] = o[i] * rstd * g4[i] * silu_f(rr[i]); }
                *(unsigned long long*)(XN2 + row * D + col) = (unsigned long long)pk2(o[0], o[1]) | ((unsigned long long)pk2(o[2], o[3]) << 32); } }
        if (BOTH(5)) GRID_BAR();
    }

    if (IN(6)) { KA_LOAD();
        pg8::Gemm g{XN2, WTO0, M, D, D}; pg8::StaticOrder S; S.init(M, D, G, bx);
        pg8::EpiResid E{x, out, D, MOD + 2048};
        pg8::gemm_phase<pg8::EpiResid, pg8::StaticOrder, true, true>(lds + RING_OFF, g, S, E);
        if (BOTH(6)) GRID_BAR();
    }

    if (IN(7)) { KA_LOAD(); PRENORM(out, 1, false); if (BOTH(7)) GRID_BAR(); }

    for (int p = 0; p <= NPART; ++p) {
        const int kA = 8 + 2 * p;
        if (IN(kA)) { KA_LOAD();
            if (p > 0) {
                const size_t prow0 = (size_t)(p - 1) * MP;
                for (int r = 0; r < 4; ++r) { const size_t row = (size_t)gw * 4 + r;
#pragma unroll
                    for (int j = 0; j < 4; ++j) { const int col = 256 * j + 4 * lane, hh = col >> 6;
                        const float l0 = LSE[(0 * (size_t)MP + row) * 16 + hh], l1 = LSE[(1 * (size_t)MP + row) * 16 + hh], l2 = LSE[(2 * (size_t)MP + row) * 16 + hh];
                        const float mx = fmaxf(l0, fmaxf(l1, l2)); float w0 = exp2f(l0 - mx), w1 = exp2f(l1 - mx), w2 = exp2f(l2 - mx); const float inv = 1.f / (w0 + w1 + w2); w0 *= inv; w1 *= inv; w2 *= inv;
                        const unsigned long long o0 = *(const unsigned long long*)(OG + (0 * (size_t)MP + row) * D + col), o1 = *(const unsigned long long*)(OG + (1 * (size_t)MP + row) * D + col), o2 = *(const unsigned long long*)(OG + (2 * (size_t)MP + row) * D + col);
                        const unsigned long long gb = *(const unsigned long long*)(GATE + (prow0 + row) * D + col);
                        float o[4];
#pragma unroll
                        for (int i = 0; i < 4; ++i) o[i] = (w0 * bf2f((bf16)(o0 >> (16 * i))) + w1 * bf2f((bf16)(o1 >> (16 * i))) + w2 * bf2f((bf16)(o2 >> (16 * i)))) * bf2f((bf16)(gb >> (16 * i)));
                        *(unsigned long long*)(XN2 + (prow0 + row) * D + col) = (unsigned long long)pk2(o[0], o[1]) | ((unsigned long long)pk2(o[2], o[3]) << 32); } }
            }
            if (p < NPART) {
                pg8::Gemm g{XN + (size_t)p * MP * D, WT1, MP, DSW_IN, D}; pg8::StaticOrder S; S.init(MP, DSW_IN, G, bx);
                pg8::EpiQkvGate E{QKV1, GATE + (size_t)p * MP * D, QSCALE1};
                pg8::gemm_phase<pg8::EpiQkvGate, pg8::StaticOrder, true, true>(lds + RING_OFF, g, S, E);
            }
            if (BOTH(kA)) GRID_BAR();
        }
        const int kB = 9 + 2 * p;
        if (p < NPART && IN(kB)) { KA_LOAD();
            constexpr int AT_K = 0, AT_V = 49152, AT_BIAS = 98304, AT_WSF = 99328, AT_OST = 101376;
            for (int it = 0; it < 6; ++it) {
                int lane_o = lane; asm volatile("" : "+v"(lane_o));
                const int r32 = lane_o & 31, hi = lane_o >> 5;
                const int quad = vcu >> 2, wq = vcu & 3, bl = quad >> 4, h = quad & 15, kind = wq + 4 * it;
                const int g = kind >> 3, kk = kind & 7, dil = g == 0 ? 1 : (g == 1 ? 4 : 16);
                const size_t rowbase = (size_t)bl * SEQ;
                {
                    const int pp = tid & 255; const bool isv = tid >= 256;
                    const int key = isv ? (16 * ((pp >> 6) & 1) + ((pp >> 2) & 15)) : (pp & 31);
                    const int coff = isv ? (2048 + (pp >> 7) * 32 + (pp & 3) * 8) : (1024 + (pp >> 5) * 8);
#pragma unroll 4
                    for (int T = 0; T < 12; ++T) {
                        int res, start;
                        if (g == 2) { res = 2 * kk + (T >= 8 ? 1 : 0); start = T >= 4 ? 32 * ((T - 4) & 3) : -1; }
                        else { res = g == 0 ? 0 : (kk >> 1); start = (g == 0 ? 256 * kk : 256 * (kk & 1)) - 128 + 32 * T; }
                        if (start >= 0) { const size_t row = rowbase + (size_t)(start + key) * dil + res;
                            *(LAS v4u*)(lds + (isv ? AT_V : AT_K) + T * 4096 + pp * 16) = *(const v4u*)(QKV1 + row * NQKV1 + g * 3072 + h * 64 + coff); }
                    }
                    if (tid < 192) ((LAS float*)(lds + AT_BIAS))[tid] = (tid >= 32 && tid <= 160) ? BIAS[(g * 16 + h) * 132 + tid - 32] : 0.f;
                }
                __syncthreads();
                {
                    const int rw = g == 2 ? 2 * kk + (wave >> 2) : (g == 0 ? 0 : (kk >> 1));
                    const int iq0 = g == 2 ? 32 * (wave & 3) : (g == 0 ? 256 * kk : 256 * (kk & 1)) + 32 * wave;
                    const size_t qrow = rowbase + (size_t)(iq0 + r32) * dil + rw;
                    bf16x8 qf[4];
#pragma unroll
                    for (int d0 = 0; d0 < 4; ++d0) qf[d0] = *(const bf16x8*)(QKV1 + qrow * NQKV1 + g * 3072 + h * 64 + 16 * d0 + 8 * hi);
                    const LAS float* bs = (const LAS float*)(lds + AT_BIAS);
                    f32x16 pt[5];
#pragma unroll
                    for (int kt = 0; kt < 5; ++kt) {
                        const bool valid = iq0 - 128 + 32 * kt >= 0;
                        if (valid) {
#pragma unroll
                            for (int r = 0; r < 16; ++r) pt[kt][r] = bs[(r32 - 4 * hi + 4) + (128 - 32 * kt - ((r & 3) + 8 * (r >> 2)) + 28)];
                            const LAS unsigned char* kb = lds + AT_K + (wave + kt) * 4096 + hi * 512 + r32 * 16;
#pragma unroll
                            for (int d0 = 0; d0 < 4; ++d0) { const bf16x8 kf = *(const LAS bf16x8*)(kb + d0 * 1024); pt[kt] = __builtin_amdgcn_mfma_f32_32x32x16_bf16(kf, qf[d0], pt[kt], 0, 0, 0); }
                            if (kt == 0) {
#pragma unroll
                                for (int r = 0; r < 16; ++r) if (((r & 3) + 8 * (r >> 2) + 4 * hi) < r32) pt[kt][r] = -INFINITY; }
                            if (kt == 4) {
#pragma unroll
                                for (int r = 0; r < 16; ++r) if (((r & 3) + 8 * (r >> 2) + 4 * hi) > r32) pt[kt][r] = -INFINITY; }
                        } else {
#pragma unroll
                            for (int r = 0; r < 16; ++r) pt[kt][r] = -INFINITY;
                        }
                    }
                    float mx = -INFINITY;
#pragma unroll
                    for (int kt = 0; kt < 5; ++kt)
#pragma unroll
                        for (int r = 0; r < 16; ++r) mx = fmaxf(mx, pt[kt][r]);
                    mx = fmaxf(mx, __shfl_xor(mx, 32));
                    float lsum = 0.f;
#pragma unroll
                    for (int kt = 0; kt < 5; ++kt)
#pragma unroll
                        for (int r = 0; r < 16; ++r) { pt[kt][r] = __builtin_amdgcn_exp2f(pt[kt][r] - mx); lsum += pt[kt][r]; }
                    lsum += __shfl_xor(lsum, 32);
                    f32x16 o[2];
#pragma unroll
                    for (int r = 0; r < 16; ++r) { o[0][r] = 0.f; o[1][r] = 0.f; }
                    const unsigned vb = (unsigned)(uintptr_t)(lds + AT_V) + ((lane >> 4) & 1) * 32 + (lane & 3) * 8 + (4 * hi + ((lane & 15) >> 2)) * 64;
#pragma unroll
                    for (int kt = 0; kt < 5; ++kt) {
                        const bool valid = iq0 - 128 + 32 * kt >= 0;
                        if (valid) {
#pragma unroll
                            for (int s = 0; s < 2; ++s) { v4u w; w.x = pk2(pt[kt][8 * s + 0], pt[kt][8 * s + 1]); w.y = pk2(pt[kt][8 * s + 2], pt[kt][8 * s + 3]); w.z = pk2(pt[kt][8 * s + 4], pt[kt][8 * s + 5]); w.w = pk2(pt[kt][8 * s + 6], pt[kt][8 * s + 7]);
                                const bf16x8 pa = __builtin_bit_cast(bf16x8, w);
#pragma unroll
                                for (int dh = 0; dh < 2; ++dh) { const unsigned va = vb + (wave + kt) * 4096 + dh * 2048 + s * 1024; s16x4 lo, hv;
                                    asm volatile("ds_read_b64_tr_b16 %0, %1" : "=v"(lo) : "v"(va) : "memory");
                                    asm volatile("ds_read_b64_tr_b16 %0, %1 offset:512" : "=v"(hv) : "v"(va) : "memory");
                                    asm volatile("s_waitcnt lgkmcnt(0)" : "+v"(lo), "+v"(hv) :: "memory");
                                    const bf16x8 vf = (bf16x8){lo[0], lo[1], lo[2], lo[3], hv[0], hv[1], hv[2], hv[3]};
                                    o[dh] = __builtin_amdgcn_mfma_f32_32x32x16_bf16(pa, vf, o[dh], 0, 0, 0); } }
                        }
                    }
                    LAS float* wsf = (LAS float*)(lds + AT_WSF) + wave * 64;
                    if (hi == 0) wsf[r32] = lsum;
                    LDS_WAIT(); asm volatile("" ::: "memory");
                    LAS unsigned short* stg = (LAS unsigned short*)(lds + AT_OST + wave * 4096);
#pragma unroll
                    for (int r = 0; r < 16; ++r) { const int orow = (r & 3) + 8 * (r >> 2) + 4 * hi; const float rl = 1.0f / wsf[orow];
                        stg[orow * 64 + r32] = (unsigned short)f2bf(o[0][r] * rl); stg[orow * 64 + 32 + r32] = (unsigned short)f2bf(o[1][r] * rl); }
                    LDS_WAIT(); asm volatile("" ::: "memory");
#pragma unroll
                    for (int i = 0; i < 4; ++i) { const int row = i * 8 + (lane >> 3), ch = lane & 7; const v4u v = *(const LAS v4u*)(stg + row * 64 + ch * 8);
                        const size_t orow = rowbase + (size_t)(iq0 + row) * dil + rw;
                        *(v4u*)(OG + ((size_t)g * MP + orow) * D + h * 64 + ch * 8) = v; }
                    if (hi == 0) LSE[((size_t)g * MP + qrow) * 16 + h] = mx + __builtin_amdgcn_logf(lsum);
                }
                __syncthreads();
            }
            if (BOTH(kB)) GRID_BAR();
        }
    }

    if (IN(17)) { KA_LOAD();
        pg8::Gemm g{XN2, WTO1, M, D, D}; pg8::StaticOrder S; S.init(M, D, G, bx);
        pg8::EpiResid E{out, out, D, MOD + (size_t)16 * 3072 + 2048};
        pg8::gemm_phase<pg8::EpiResid, pg8::StaticOrder, true, true>(lds + RING_OFF, g, S, E);
        if (BOTH(17)) GRID_BAR();
    }

    if (IN(18)) { KA_LOAD();
        f32x4 fg[4];
#pragma unroll
        for (int j = 0; j < 4; ++j) fg[j] = *(const f32x4*)(final_g + 256 * j + 4 * lane);
        for (int r = 0; r < 16; ++r) { const size_t row = (size_t)gw * 16 + r; float* xr = out + row * D;
            f32x4 v[4]; float ss = 0.f;
#pragma unroll
            for (int j = 0; j < 4; ++j) { v[j] = *(const f32x4*)(xr + 256 * j + 4 * lane); ss += (v[j][0] * v[j][0] + v[j][1] * v[j][1]) + (v[j][2] * v[j][2] + v[j][3] * v[j][3]); }
            const float rstd = 1.0f / sqrtf(wave_sum(ss) * (1.f / D) + EPS);
#pragma unroll
            for (int j = 0; j < 4; ++j) *(f32x4*)(xr + 256 * j + 4 * lane) = v[j] * rstd * fg[j]; }
    }
#undef IN
#undef BOTH
#undef GRID_BAR
#undef PRENORM
#undef KA_LOAD
}

extern "C" void kernel_launch(void* const* d_in, const int* in_sizes, int n_in, void* d_out, int out_size, void* d_ws, size_t ws_size, hipStream_t stream) {
    static int grid = 0;
    if (grid == 0) {
        if (n_in != 14 || in_sizes[0] != M * D || out_size != M * D || ws_size < WS_END) { fprintf(stderr, "kernel_launch: unexpected problem shape / workspace (n_in %d, in0 %d, out %d, ws %zu < %zu); nothing launched\n", n_in, n_in > 0 ? in_sizes[0] : -1, out_size, ws_size, (size_t)WS_END); grid = -1; return; }
        int dev = 0, cus = 0, per_cu = 0;
        if (hipGetDevice(&dev) != hipSuccess || hipDeviceGetAttribute(&cus, hipDeviceAttributeMultiprocessorCount, dev) != hipSuccess) { fprintf(stderr, "kernel_launch: device query failed\n"); grid = -1; return; }
        if (hipFuncSetAttribute((const void*)mk_fwd, hipFuncAttributeMaxDynamicSharedMemorySize, LDS_BYTES) != hipSuccess) { fprintf(stderr, "kernel_launch: hipFuncSetAttribute failed\n"); grid = -1; return; }
        if (hipOccupancyMaxActiveBlocksPerMultiprocessor(&per_cu, (const void*)mk_fwd, NWAVES * 64, LDS_BYTES) != hipSuccess || per_cu < 1)
            fprintf(stderr, "kernel_launch: note: occupancy query reports %d workgroups per CU\n", per_cu);
        (void)hipGetLastError();
        grid = cus;
        if (grid != 256) fprintf(stderr, "kernel_launch: note: %d CUs (tuned for 256)\n", grid);
    }
    if (grid < 0) return;
    if (hipMemsetAsync((char*)d_ws + WS_CTL, 0, CTL_ZERO_BYTES, stream) != hipSuccess) { fprintf(stderr, "kernel_launch: hipMemsetAsync failed\n"); return; }
    Args a{};
    for (int i = 0; i < 14; ++i) a.in[i] = (const float*)d_in[i];
    a.out = (float*)d_out; a.ws = (unsigned char*)d_ws;
    for (int li = 0; li < N_LAUNCHES; ++li) {
        a.ph_lo = (N_LAUNCHES == 1) ? 0 : li; a.ph_hi = (N_LAUNCHES == 1) ? N_PHASES : li + 1; a.li = li;
        hipLaunchKernelGGL(mk_fwd, dim3(grid), dim3(NWAVES * 64), LDS_BYTES, stream, a);
        const hipError_t le = hipPeekAtLastError();
        if (le != hipSuccess) { fprintf(stderr, "kernel_launch: launch %d failed: %s\n", li, hipGetErrorName(le)); break; }
    }
}
```

```cpp
#include <hip/hip_runtime.h>
#include <cstdio>
#include <cstdint>
namespace pg8 {
#define PG8_LAS __attribute__((address_space(3)))
typedef unsigned short bf16_t;
typedef short bf16x8 __attribute__((ext_vector_type(8)));
typedef float f32x4 __attribute__((ext_vector_type(4)));
typedef unsigned u32x4 __attribute__((ext_vector_type(4)));
constexpr int BM = 256, BK = 64, HALF = 128, HTB = HALF * BK * 2  , STAGE_BYTES = 8 * HTB, NXCD = 8, WGM = 8;

__host__ __device__ __forceinline__ int lds_byte(int r, int c) { const int st = (r >> 4) * 2 + (c >> 5), rr = r & 15, cc = c & 31, ob = rr * 64 + cc * 2; return st * 1024 + (ob ^ (((ob >> 9) & 1) << 5)); }
__host__ __device__ __forceinline__ void stage_rc(int b, int& R, int& C) { const int st = b / 1024, sb = b % 1024, swz = sb ^ (((sb >> 9) & 1) << 5); R = (st >> 1) * 16 + swz / 64; C = (st & 1) * 32 + (swz % 64) / 2; }
__host__ __device__ __forceinline__ int perm32(int rho) { const int n = rho >> 4, i = rho & 15; return 8 * (i >> 2) + 4 * n + (i & 3); }

struct Unit { int pm, pn; };
struct Gemm { const bf16_t* A; const bf16_t* Bt; int M, N, K; };

struct StaticOrder {
    int nM, nN, nwg, G, c;
    __host__ __device__ void init(int M, int N, int G_, int c_) { nM = M / BM; nN = N / BM; nwg = nM * nN; G = G_; c = c_; }
    __host__ __device__ bool next(int i, Unit& u) const {
        const long L = (long)i * G + c; if (L >= nwg) return false;
        int wgid = (int)L; { const int q = nwg / NXCD, r = nwg % NXCD, xcd = wgid % NXCD, off = wgid / NXCD; wgid = (xcd < r ? xcd * (q + 1) : r * (q + 1) + (xcd - r) * q) + off; }
        const int nig = WGM * nN, gid = wgid / nig, fm = gid * WGM, gsz = (nM - fm) < WGM ? (nM - fm) : WGM;
        u.pm = fm + ((wgid % nig) % gsz); u.pn = (wgid % nig) / gsz; return true;
    }
    __device__ __forceinline__ void a_ready(const Unit&) const {}
    __device__ __forceinline__ void done(const Unit&) const {}
};

__device__ __forceinline__ unsigned cvt_pk_bf16(float lo, float hi) { unsigned r; asm volatile("v_cvt_pk_bf16_f32 %0, %1, %2" : "=v"(r) : "v"(lo), "v"(hi)); return r; }

struct EpiBf16S {
    static constexpr bool PERM = true, AFTER_DRAIN = false;
    bf16_t* O; int ldc; int nscale; float scale0;
    __device__ __forceinline__ void operator()(const f32x4 (&acc)[2][2][4][2], const Unit& u, int wr, int wc, int fr, int fq) const {
        const int row0 = u.pm * BM + wr * 64 + fr, col0 = u.pn * BM + wc * 32 + 8 * fq;
        const float sc = (u.pn < nscale) ? scale0 : 1.f;
#pragma unroll
        for (int ai = 0; ai < 2; ++ai)
#pragma unroll
            for (int m = 0; m < 4; ++m) { bf16_t* rowp = O + (size_t)(row0 + ai * HALF + m * 16) * ldc + col0;
#pragma unroll
                for (int bj = 0; bj < 2; ++bj) { const f32x4 v0 = acc[ai][bj][m][0] * sc, v1 = acc[ai][bj][m][1] * sc;
                    u32x4 w; w.x = cvt_pk_bf16(v0[0], v0[1]); w.y = cvt_pk_bf16(v0[2], v0[3]); w.z = cvt_pk_bf16(v1[0], v1[1]); w.w = cvt_pk_bf16(v1[2], v1[3]);
                    *(u32x4*)(rowp + bj * HALF) = w; } }
    }
};
struct EpiQkvGate {
    static constexpr bool PERM = true, AFTER_DRAIN = false;
    bf16_t* QKV; bf16_t* G; float qscale; int nostore;
    __device__ __forceinline__ void operator()(const f32x4 (&acc)[2][2][4][2], const Unit& u, int wr, int wc, int fr, int fq) const {
        const int row0 = u.pm * BM + wr * 64 + fr;
        const bool isg = u.pn >= 12;
        const int ldc = isg ? 1024 : 3072;
        const int col0 = (isg ? (u.pn - 12) : u.pn) * BM + wc * 32 + 8 * fq;
        bf16_t* base = isg ? G : QKV;
        const float sc = (u.pn < 4) ? qscale : 1.f;
#pragma unroll
        for (int ai = 0; ai < 2; ++ai)
#pragma unroll
            for (int m = 0; m < 4; ++m) { bf16_t* rowp = base + (size_t)(row0 + ai * HALF + m * 16) * ldc + col0;
#pragma unroll
                for (int bj = 0; bj < 2; ++bj) { f32x4 v0 = acc[ai][bj][m][0] * sc, v1 = acc[ai][bj][m][1] * sc;
                    if (isg) {
#pragma unroll
                        for (int e = 0; e < 4; ++e) { v0[e] = v0[e] * __builtin_amdgcn_rcpf(1.f + __builtin_amdgcn_exp2f(-1.4426950408889634f * v0[e]));
                                                      v1[e] = v1[e] * __builtin_amdgcn_rcpf(1.f + __builtin_amdgcn_exp2f(-1.4426950408889634f * v1[e])); } }
                    u32x4 w; w.x = cvt_pk_bf16(v0[0], v0[1]); w.y = cvt_pk_bf16(v0[2], v0[3]); w.z = cvt_pk_bf16(v1[0], v1[1]); w.w = cvt_pk_bf16(v1[2], v1[3]);
                    if (!nostore) *(u32x4*)(rowp + bj * HALF) = w; else asm volatile("" :: "v"(w)); } }
    }
};
struct EpiResid {
    static constexpr bool PERM = false, AFTER_DRAIN = false;
    const float* base; float* out; int ldc; const float* gate;
    __device__ __forceinline__ void operator()(const f32x4 (&acc)[2][2][4][2], const Unit& u, int wr, int wc, int fr, int fq) const {
        const int row0 = u.pm * BM + wr * 64 + fr, col0 = u.pn * BM + wc * 32 + 4 * fq;
        const float* gp = gate + (size_t)(u.pm >> 3) * 3072 + col0;
        f32x4 gv[2][2];
#pragma unroll
        for (int bj = 0; bj < 2; ++bj)
#pragma unroll
            for (int n = 0; n < 2; ++n) gv[bj][n] = *(const f32x4*)(gp + bj * HALF + n * 16);
#pragma unroll
        for (int ai = 0; ai < 2; ++ai)
#pragma unroll
            for (int m = 0; m < 4; ++m) { const size_t off = (size_t)(row0 + ai * HALF + m * 16) * ldc + col0;
#pragma unroll
                for (int bj = 0; bj < 2; ++bj)
#pragma unroll
                    for (int n = 0; n < 2; ++n) { const f32x4 bs = *(const f32x4*)(base + off + bj * HALF + n * 16); *(f32x4*)(out + off + bj * HALF + n * 16) = bs + gv[bj][n] * acc[ai][bj][m][n]; }
                if (m & 1) asm volatile("" ::: "memory"); }
    }
};

template <class Epi, class Sched, bool ALIGN_EPI = false, bool SP2 = false>
__device__ __forceinline__ void gemm_phase(PG8_LAS unsigned char* lds, const Gemm g, const Sched& S, const Epi& E) {
    int tid_o = threadIdx.x; asm volatile("" : "+v"(tid_o));
    const int tid = tid_o, wid = __builtin_amdgcn_readfirstlane(tid >> 6), lane = tid & 63, wr = wid >> 2, wc = wid & 3, fr = lane & 15, fq = lane >> 4;
    const int K = g.K, nt = K / BK;
    unsigned voffA[2], voffB[2];
#pragma unroll
    for (int i = 0; i < 2; ++i) { int R, C; stage_rc(tid * 16 + i * 8192, R, C); const int Rb = Epi::PERM ? ((R & ~31) + perm32(R & 31)) : R;
        voffA[i] = (unsigned)(R * K + C) * 2u; voffB[i] = (unsigned)(Rb * K + C) * 2u; }
    const size_t kstep = (size_t)(BK * 2);
    const size_t hstep = (size_t)HALF * K * 2;
    const size_t tstep = 2 * hstep;
    const unsigned ldsw = (unsigned)wid * 1024u;
    const int aoff = lds_byte(wr * 64 + fr, fq * 8), boff = lds_byte(wc * 32 + fr, fq * 8);
#define PG8_SA(b, h) (((b) * 2 + (h)) * HTB)
#define PG8_SB(b, h) ((4 + (b) * 2 + (h)) * HTB)
#define PG8_STAGE(bufoff, gbase, voff) do { _Pragma("unroll") for (int _i = 0; _i < 2; ++_i) \
        __builtin_amdgcn_global_load_lds((const unsigned*)((const char*)(gbase) + (voff)[_i]), (PG8_LAS unsigned*)(lds + (bufoff) + ldsw + _i * 8192), 16, 0, 0); } while (0)
#define PG8_LDA(dst, b, h) do { _Pragma("unroll") for (int m = 0; m < 4; ++m) _Pragma("unroll") for (int k = 0; k < 2; ++k) dst[m][k] = *(const PG8_LAS bf16x8*)(lds + PG8_SA(b, h) + aoff + m * 2048 + k * 1024); } while (0)
#define PG8_LDB(dst, b, h) do { _Pragma("unroll") for (int n = 0; n < 2; ++n) _Pragma("unroll") for (int k = 0; k < 2; ++k) dst[n][k] = *(const PG8_LAS bf16x8*)(lds + PG8_SB(b, h) + boff + n * 2048 + k * 1024); } while (0)
#define PG8_MMA(ai, bj, At, Bt) do { __builtin_amdgcn_s_setprio(1); _Pragma("unroll") for (int m = 0; m < 4; ++m) _Pragma("unroll") for (int n = 0; n < 2; ++n) _Pragma("unroll") for (int k = 0; k < 2; ++k) \
        acc[ai][bj][m][n] = __builtin_amdgcn_mfma_f32_16x16x32_bf16(Bt[n][k], At[m][k], acc[ai][bj][m][n], 0, 0, 0); __builtin_amdgcn_s_setprio(0); } while (0)
#define PG8_WAIT_V(n) asm volatile("s_waitcnt vmcnt(" #n ")" ::: "memory")
#define PG8_WAIT_L(n) asm volatile("s_waitcnt lgkmcnt(" #n ")" ::: "memory")
#define PG8_BAR __builtin_amdgcn_s_barrier()
#define PG8_SCHED __builtin_amdgcn_sched_barrier(0)
    Unit cur, nxt; int ui = 0;
    if (!S.next(0, cur)) return;
    f32x4 acc[2][2][4][2];
#pragma unroll
    for (int a = 0; a < 2; ++a)
#pragma unroll
        for (int b = 0; b < 2; ++b)
#pragma unroll
            for (int m = 0; m < 4; ++m)
#pragma unroll
                for (int n = 0; n < 2; ++n) acc[a][b][m][n] = (f32x4){0.f, 0.f, 0.f, 0.f};
    bf16x8 At[4][2], B0[2][2], B1[2][2];
    const char* cA = (const char*)g.A + (size_t)cur.pm * tstep; const char* cB = (const char*)g.Bt + (size_t)cur.pn * tstep;
    S.a_ready(cur);
    if constexpr (SP2) {
        PG8_STAGE(PG8_SB(0, 0), cB, voffB); PG8_STAGE(PG8_SB(0, 1), cB + hstep, voffB); PG8_STAGE(PG8_SA(0, 0), cA, voffA); PG8_STAGE(PG8_SA(0, 1), cA + hstep, voffA);
        if (wr == 1) PG8_BAR;
        PG8_WAIT_V(2); PG8_BAR;
        PG8_STAGE(PG8_SB(1, 0), cB + kstep, voffB); PG8_STAGE(PG8_SA(1, 0), cA + kstep, voffA); PG8_STAGE(PG8_SB(1, 1), cB + hstep + kstep, voffB);
        PG8_WAIT_V(6); PG8_BAR;
    } else {
        PG8_STAGE(PG8_SB(0, 0), cB, voffB); PG8_STAGE(PG8_SA(0, 0), cA, voffA); PG8_STAGE(PG8_SB(0, 1), cB + hstep, voffB); PG8_STAGE(PG8_SA(0, 1), cA + hstep, voffA);
        if (wr == 1) PG8_BAR;
        PG8_WAIT_V(4); PG8_BAR;
        PG8_STAGE(PG8_SB(1, 0), cB + kstep, voffB); PG8_STAGE(PG8_SA(1, 0), cA + kstep, voffA); PG8_STAGE(PG8_SB(1, 1), cB + hstep + kstep, voffB);
        PG8_WAIT_V(6); PG8_BAR;
    }
    for (;;) {
        const bool has_next = S.next(ui + 1, nxt);
        const char* nA = has_next ? (const char*)g.A + (size_t)nxt.pm * tstep : cA; const char* nB = has_next ? (const char*)g.Bt + (size_t)nxt.pn * tstep : cB;
        for (int t = 0; t < nt; t += 2) {
            const bool last = (t == nt - 2);
            const char* a1 = cA + (size_t)(t + 1) * kstep;
            const char* a2 = last ? nA : cA + (size_t)(t + 2) * kstep; const char* b2 = last ? nB : cB + (size_t)(t + 2) * kstep;
            const char* a3 = a2 + kstep; const char* b3 = b2 + kstep;
            if (last && has_next) S.a_ready(nxt);
            if constexpr (SP2) {
            PG8_LDB(B0, 0, 0); PG8_LDB(B1, 0, 1); PG8_SCHED; PG8_LDA(At, 0, 0); PG8_STAGE(PG8_SA(1, 1), a1 + hstep, voffA);
            PG8_WAIT_V(8); PG8_WAIT_L(0); PG8_BAR; PG8_MMA(0, 0, At, B0); PG8_MMA(0, 1, At, B1); PG8_BAR; PG8_SCHED;
            PG8_LDA(At, 0, 1); PG8_STAGE(PG8_SB(0, 0), b2, voffB); PG8_STAGE(PG8_SB(0, 1), b2 + hstep, voffB); PG8_STAGE(PG8_SA(0, 0), a2, voffA);
            PG8_WAIT_V(8); PG8_WAIT_L(0); PG8_BAR; PG8_MMA(1, 0, At, B0); PG8_MMA(1, 1, At, B1); PG8_BAR; PG8_SCHED;
            PG8_LDB(B0, 1, 0); PG8_LDB(B1, 1, 1); PG8_SCHED; PG8_LDA(At, 1, 0); PG8_STAGE(PG8_SA(0, 1), a2 + hstep, voffA);
            PG8_WAIT_V(8); PG8_WAIT_L(0); PG8_BAR; PG8_MMA(0, 0, At, B0); PG8_MMA(0, 1, At, B1); PG8_BAR; PG8_SCHED;
            PG8_LDA(At, 1, 1); PG8_STAGE(PG8_SB(1, 0), b3, voffB); PG8_STAGE(PG8_SB(1, 1), b3 + hstep, voffB); PG8_STAGE(PG8_SA(1, 0), a3, voffA);
            PG8_WAIT_V(8); PG8_WAIT_L(0); PG8_BAR; PG8_MMA(1, 0, At, B0); PG8_MMA(1, 1, At, B1); PG8_BAR; PG8_SCHED;
            } else {
            PG8_LDB(B0, 0, 0); PG8_SCHED; PG8_LDA(At, 0, 0); PG8_STAGE(PG8_SA(1, 1), a1 + hstep, voffA);
            PG8_WAIT_L(8); PG8_BAR; PG8_WAIT_L(0); PG8_MMA(0, 0, At, B0); PG8_BAR; PG8_SCHED;
            PG8_LDB(B1, 0, 1); PG8_STAGE(PG8_SB(0, 0), b2, voffB);
            PG8_BAR; PG8_WAIT_L(0); PG8_MMA(0, 1, At, B1); PG8_BAR;
            PG8_LDA(At, 0, 1); PG8_STAGE(PG8_SA(0, 0), a2, voffA);
            PG8_BAR; PG8_WAIT_L(0); PG8_MMA(1, 0, At, B0); PG8_BAR; PG8_SCHED;
            PG8_STAGE(PG8_SB(0, 1), b2 + hstep, voffB);
            PG8_WAIT_V(6); PG8_BAR; PG8_MMA(1, 1, At, B1); PG8_BAR;
            PG8_LDB(B0, 1, 0); PG8_SCHED; PG8_LDA(At, 1, 0); PG8_STAGE(PG8_SA(0, 1), a2 + hstep, voffA);
            PG8_WAIT_L(8); PG8_BAR; PG8_WAIT_L(0); PG8_MMA(0, 0, At, B0); PG8_BAR; PG8_SCHED;
            PG8_LDB(B1, 1, 1); PG8_STAGE(PG8_SB(1, 0), b3, voffB);
            PG8_BAR; PG8_WAIT_L(0); PG8_MMA(0, 1, At, B1); PG8_BAR;
            PG8_LDA(At, 1, 1); PG8_STAGE(PG8_SA(1, 0), a3, voffA);
            PG8_BAR; PG8_WAIT_L(0); PG8_MMA(1, 0, At, B0); PG8_BAR; PG8_SCHED;
            PG8_STAGE(PG8_SB(1, 1), b3 + hstep, voffB);
            PG8_WAIT_V(6); PG8_BAR; PG8_MMA(1, 1, At, B1); PG8_BAR;
            }
        }
        if constexpr (ALIGN_EPI) { if (wr == 0) PG8_BAR; }
        if constexpr (!Epi::AFTER_DRAIN) { E(acc, cur, wr, wc, fr, fq); S.done(cur); }
        if (!has_next) break;
#pragma unroll
        for (int a = 0; a < 2; ++a)
#pragma unroll
            for (int b = 0; b < 2; ++b)
#pragma unroll
                for (int m = 0; m < 4; ++m)
#pragma unroll
                    for (int n = 0; n < 2; ++n) acc[a][b][m][n] = (f32x4){0.f, 0.f, 0.f, 0.f};
        cur = nxt; cA = nA; cB = nB; ++ui;
        if constexpr (ALIGN_EPI) { if (wr == 1) PG8_BAR; }
    }
    PG8_WAIT_V(0);
    if constexpr (!ALIGN_EPI) { if (wr == 0) PG8_BAR; }
    PG8_BAR;
    if constexpr (Epi::AFTER_DRAIN) { E.fused(acc, cur, wr, wc, fr, fq, lds, wid, lane); S.done(cur); }
#undef PG8_SA
#undef PG8_SB
#undef PG8_STAGE
#undef PG8_LDA
#undef PG8_LDB
#undef PG8_MMA
#undef PG8_WAIT_V
#undef PG8_WAIT_L
#undef PG8_BAR
#undef PG8_SCHED
}
}
#define GAS __attribute__((address_space(1)))
#define LAS __attribute__((address_space(3)))
typedef unsigned short bf16;
typedef unsigned v4u __attribute__((ext_vector_type(4)));
typedef float f32x4 __attribute__((ext_vector_type(4)));
typedef short bf16x8 __attribute__((ext_vector_type(8)));
typedef GAS unsigned gu32;
typedef GAS unsigned long long gu64;
#define RLX_AGENT __ATOMIC_RELAXED, __HIP_MEMORY_SCOPE_AGENT
#define LDS_WAIT() asm volatile("s_waitcnt lgkmcnt(0)" ::: "memory")
#define VM_WAIT() asm volatile("s_waitcnt vmcnt(0)" ::: "memory")
__device__ __forceinline__ unsigned long long rt() { return __builtin_amdgcn_s_memrealtime(); }
__device__ __forceinline__ unsigned f2bf(float f) { unsigned u = __builtin_bit_cast(unsigned, f); return (u + 0x7fffu + ((u >> 16) & 1u)) >> 16; }
__device__ __forceinline__ unsigned pk2(float lo, float hi) { return f2bf(lo) | (f2bf(hi) << 16); }

#define XB_TMO      128
#define XB_XCNT(j)  (256  + 64 * (j))
#define XB_XSUB(j)  (1280 + 64 * (j))
#define XB_XGEN(j)  (2304 + 64 * (j))
#define XB_TOP      3328
#define XB_TOPGEN   3392
#define XCD_BAR_WORDS 3456
#define XB_SPIN_CAP (1u << 18)

__device__ __forceinline__ unsigned xb_ld(unsigned* p)              { return __hip_atomic_load(p, __ATOMIC_RELAXED, __HIP_MEMORY_SCOPE_AGENT); }
__device__ __forceinline__ unsigned xb_add(unsigned* p, unsigned v) { return __hip_atomic_fetch_add(p, v, __ATOMIC_RELAXED, __HIP_MEMORY_SCOPE_AGENT); }
__device__ __forceinline__ unsigned xb_xcc_id() { return (unsigned)__builtin_amdgcn_s_getreg((3 << 11) | 20) & 0xFu; }
#define XB_SPIN(cond, bar) do { unsigned _sp = 0; while (cond) { __builtin_amdgcn_s_sleep(1); \
    if ((++_sp & 255u) == 0u) { if (xb_ld(&(bar)[XB_TMO])) break; if (_sp > XB_SPIN_CAP) { atomicAdd(&(bar)[XB_TMO], 1u); break; } } } } while (0)

struct XcdBarrier {
    unsigned* bar; unsigned x;
    volatile LAS unsigned* st;
};

__device__ __forceinline__ XcdBarrier xcd_barrier_post(unsigned* bar, volatile LAS unsigned* st) {
    XcdBarrier b; b.bar = bar; b.x = xb_xcc_id(); b.st = st;
    if (threadIdx.x == 0) (void)xb_add(&bar[XB_XCNT(b.x)], 1u);
    return b;
}
__device__ __forceinline__ void xcd_barrier_complete(unsigned* bar, unsigned x, unsigned& nloc, unsigned& nx) {
    const unsigned G = gridDim.x * gridDim.y * gridDim.z;
    unsigned sum, cnt, mine, sp = 0u;
    for (;;) {
        sum = 0u; cnt = 0u; mine = 0u;
#pragma unroll
        for (unsigned j = 0; j < 16; ++j) { const unsigned c = xb_ld(&bar[XB_XCNT(j)]); sum += c; cnt += (c > 0u) ? 1u : 0u; mine = (j == x) ? c : mine; }
        if (sum == G) break;
        __builtin_amdgcn_s_sleep(1);
        if ((++sp & 255u) == 0u) { if (xb_ld(&bar[XB_TMO])) break; if (sp > XB_SPIN_CAP) { atomicAdd(&bar[XB_TMO], 1u); break; } }
    }
    nloc = mine > 0u ? mine : 1u; nx = cnt > 0u ? cnt : 1u;
}

__device__ __forceinline__ void xcd_barrier(const XcdBarrier& b) {
    asm volatile("s_waitcnt vmcnt(0)" ::: "memory");
    __syncthreads();
    if (threadIdx.x == 0) {
        unsigned* bar = b.bar;
        __builtin_amdgcn_s_waitcnt(0);
        unsigned nloc = b.st[0], nx = b.st[1];
        if (nloc == 0u) { xcd_barrier_complete(bar, b.x, nloc, nx); b.st[0] = nloc; b.st[1] = nx; }
        const unsigned old = xb_add(&bar[XB_XSUB(b.x)], 1u);
        const unsigned gen = old / nloc;
        if (old + 1u == (gen + 1u) * nloc) {
            __builtin_amdgcn_fence(__ATOMIC_RELEASE, "agent");
            asm volatile("s_waitcnt vmcnt(0)" ::: "memory");
            const unsigned og = xb_add(&bar[XB_TOP], 1u);
            const unsigned tg = og / nx;
            if (og + 1u == (tg + 1u) * nx) xb_add(&bar[XB_TOPGEN], 1u);
            else XB_SPIN(xb_ld(&bar[XB_TOPGEN]) == tg, bar);
            __builtin_amdgcn_fence(__ATOMIC_ACQUIRE, "agent");
            xb_add(&bar[XB_XGEN(b.x)], 1u);
            asm volatile("s_waitcnt vmcnt(0)" ::: "memory");
        } else {
            XB_SPIN(xb_ld(&bar[XB_XGEN(b.x)]) == gen, bar);
            __builtin_amdgcn_fence(__ATOMIC_ACQUIRE, "agent");
            asm volatile("s_waitcnt vmcnt(0)" ::: "memory");
        }
    }
    __syncthreads();
}

constexpr int NWAVES = 8;
constexpr int BATCH = 16, SEQ = 2048, D = 1024, M = BATCH * SEQ;
constexpr int GLA_IN = 3088, N0 = 3072;
constexpr int DSW_IN = 10240, NQKV1 = 9216;
constexpr float EPS = 1e-6f, LOG2E = 1.4426950408889634f;
constexpr float QSCALE0 = 0.08838834764831845f;
constexpr float QSCALE1 = 0.125f * LOG2E;

constexpr size_t MiB = 1u << 20;
constexpr size_t WS_CTL = 0, CTL_ZERO_BYTES = 1 * MiB;
constexpr size_t WS_MOD = 1 * MiB;
constexpr size_t WS_BIAS = 1 * MiB + 512 * 1024;
constexpr size_t WS_WT0 = 2 * MiB, WS_WT1 = 8 * MiB, WS_WTO0 = 28 * MiB, WS_WTO1 = 30 * MiB;
constexpr size_t WS_XN = 32 * MiB;
constexpr size_t WS_XN2 = 96 * MiB;
constexpr size_t WS_BIG = 160 * MiB;
constexpr size_t WS_QKVR = WS_BIG;
constexpr size_t WS_AM = WS_BIG + 192 * MiB;
constexpr size_t WS_QS = WS_BIG + 208 * MiB;
constexpr size_t WS_KST = WS_BIG + 240 * MiB;
constexpr size_t WS_DEC = WS_BIG + 272 * MiB;
constexpr size_t WS_SSQ = WS_BIG + 280 * MiB;
constexpr size_t WS_GLR = WS_BIG + 276 * MiB;
constexpr size_t WS_QKV1 = WS_BIG;
constexpr size_t WS_GATE = WS_BIG + 192 * MiB;
constexpr size_t WS_LSEACC = WS_BIG + 256 * MiB;
constexpr size_t WS_END = WS_BIG + 288 * MiB;
constexpr int CW_BAR = 4096;

constexpr int RING_OFF = 0, RING_BYTES = 131072;
constexpr int LDSCTL_OFF = 139264, MISC_OFF = LDSCTL_OFF + 320;
constexpr int LDS_BYTES = 147456;

typedef short s16x4 __attribute__((ext_vector_type(4)));
typedef float f32x16 __attribute__((ext_vector_type(16)));
template <class T> __device__ __forceinline__ T* as_global(T* p) { return (T*)(GAS T*)p; }
__device__ __forceinline__ float bf2f(bf16 b) { return __uint_as_float((unsigned)b << 16); }
__device__ __forceinline__ float wave_sum(float v) {
#pragma unroll
    for (int o = 1; o < 64; o <<= 1) v += __shfl_xor(v, o);
    return v;
}
__device__ __forceinline__ float wave_max(float v) {
#pragma unroll
    for (int o = 1; o < 64; o <<= 1) v = fmaxf(v, __shfl_xor(v, o));
    return v;
}
__device__ __forceinline__ float row16_sum(float x) {
    x += __builtin_bit_cast(float, __builtin_amdgcn_update_dpp(0, __builtin_bit_cast(int, x), 0xB1, 0xf, 0xf, false));
    x += __builtin_bit_cast(float, __builtin_amdgcn_update_dpp(0, __builtin_bit_cast(int, x), 0x4E, 0xf, 0xf, false));
    x += __builtin_bit_cast(float, __builtin_amdgcn_update_dpp(0, __builtin_bit_cast(int, x), 0x141, 0xf, 0xf, false));
    x += __builtin_bit_cast(float, __builtin_amdgcn_update_dpp(0, __builtin_bit_cast(int, x), 0x140, 0xf, 0xf, false));
    return x;
}
__device__ __forceinline__ float silu_f(float v) { return v / (1.f + __expf(-v)); }

__device__ __forceinline__ void transpose_item(const float* W, int ldw, int scol0, int K, bf16* WT, int drow0, LAS float* scr, int kb, int nb, int lane) {
    const int k0 = 64 * kb, n0 = 32 * nb;
#pragma unroll 8
    for (int i = 0; i < 32; ++i) { const int kk = 2 * i + (lane >> 5); scr[kk * 33 + (lane & 31)] = W[(size_t)(k0 + kk) * ldw + scol0 + n0 + (lane & 31)]; }
    LDS_WAIT(); asm volatile("" ::: "memory");
    const int c = lane & 7;
#pragma unroll
    for (int j = 0; j < 4; ++j) { const int n = (lane >> 3) + 8 * j; const LAS float* s = scr + (8 * c) * 33 + n;
        v4u o; o.x = pk2(s[0 * 33], s[1 * 33]); o.y = pk2(s[2 * 33], s[3 * 33]); o.z = pk2(s[4 * 33], s[5 * 33]); o.w = pk2(s[6 * 33], s[7 * 33]);
        *(GAS v4u*)(WT + (size_t)(drow0 + n0 + n) * K + k0 + 8 * c) = o; }
    LDS_WAIT(); asm volatile("" ::: "memory");
}
__device__ __forceinline__ int t5_bucket(int n) {
    if (n < 16) return n;
    int b = 16;
    b += (n >= 22); b += (n >= 30); b += (n >= 40); b += (n >= 54); b += (n >= 73); b += (n >= 99); b += (n >= 134); b += (n >= 182);
    b += (n >= 246); b += (n >= 332); b += (n >= 450); b += (n >= 609); b += (n >= 825); b += (n >= 1117); b += (n >= 1513);
    return b;
}

__device__ __forceinline__ float reduce16(const float (&a)[16], int lane, int& col) {
    float b8[8], b4[4], b2[2], b1;
    const bool h5 = (lane & 32) != 0, h4 = (lane & 16) != 0, h3 = (lane & 8) != 0, h2 = (lane & 4) != 0;
#pragma unroll
    for (int c = 0; c < 8; ++c) { const float keep = h5 ? a[c + 8] : a[c], send = h5 ? a[c] : a[c + 8]; b8[c] = keep + __shfl_xor(send, 32); }
#pragma unroll
    for (int c = 0; c < 4; ++c) { const float keep = h4 ? b8[c + 4] : b8[c], send = h4 ? b8[c] : b8[c + 4]; b4[c] = keep + __shfl_xor(send, 16); }
#pragma unroll
    for (int c = 0; c < 2; ++c) { const float keep = h3 ? b4[c + 2] : b4[c], send = h3 ? b4[c] : b4[c + 2]; b2[c] = keep + __shfl_xor(send, 8); }
    { const float keep = h2 ? b2[1] : b2[0], send = h2 ? b2[0] : b2[1]; b1 = keep + __shfl_xor(send, 4); }
    b1 += __shfl_xor(b1, 2); b1 += __shfl_xor(b1, 1);
    col = (h5 ? 8 : 0) + (h4 ? 4 : 0) + (h3 ? 2 : 0) + (h2 ? 1 : 0);
    return b1;
}

template <int g> __device__ __forceinline__ void attn_group(LAS unsigned char* lds, const bf16* QKV1, const float* BIAS, bf16* XN2, const bf16* GATE, float* LSEACC, int vcu, int tid, int lane, int wave) {
            constexpr int AT_K = 0, AT_V = 49152, AT_BIAS = 98304, AT_WSF = 99328, AT_OST = 101376;
            const int b = vcu >> 4, h = vcu & 15; constexpr int dil = g == 0 ? 1 : (g == 1 ? 4 : 16);
            const size_t rowbase = (size_t)b * SEQ;
            const int pp = tid & 255, sl0 = wave >> 2;
            const int kkey = pp >> 3, kcoff = 1024 + (pp & 7) * 8, kdst = (pp >> 3) * 128 + (((pp & 7) ^ ((pp >> 3) & 7)) * 16);
            const int vkey = pp >> 3, vcoff = 2048 + (pp & 7) * 8, vdst = ((pp >> 2) & 1) * 2048 + (pp >> 7) * 1024 + ((pp >> 3) & 15) * 64 + (pp & 3) * 16;
            const bf16* hb = QKV1 + h * 64;
#define AT_SLOT(kk_, T_, res_, start_) do { if (g == 2) { res_ = 2 * (kk_) + ((T_) >= 8 ? 1 : 0); start_ = (T_) >= 4 ? 32 * (((T_) - 4) & 3) : -1; } \
                else { res_ = g == 0 ? 0 : ((kk_) >> 1); start_ = (g == 0 ? 256 * (kk_) : 256 * ((kk_) & 1)) - 128 + 32 * (T_); } } while (0)
#define AT_ISSUE(regs_, kk_, key_, coff_) do { _Pragma("unroll") for (int i_ = 0; i_ < 6; ++i_) { const int T_ = sl0 + 2 * i_; int res_, start_; AT_SLOT(kk_, T_, res_, start_); \
                if (start_ >= 0) regs_[i_] = *(const v4u*)(hb + (rowbase + (size_t)(start_ + (key_)) * dil + res_) * 3072 + (coff_)); } } while (0)
#define AT_WRITE(regs_, kk_, base_, dst_) do { _Pragma("unroll") for (int i_ = 0; i_ < 6; ++i_) { const int T_ = sl0 + 2 * i_; int res_, start_; AT_SLOT(kk_, T_, res_, start_); \
                if (start_ >= 0) *(LAS v4u*)(lds + (base_) + T_ * 4096 + (dst_)) = regs_[i_]; } } while (0)
            if (tid < 192) ((LAS float*)(lds + AT_BIAS))[tid] = (tid >= 32 && tid <= 160) ? BIAS[(g * 16 + h) * 132 + tid - 32] : 0.f;
            { v4u rk[6]; AT_ISSUE(rk, 0, kkey, kcoff); AT_WRITE(rk, 0, AT_K, kdst); }
            __syncthreads();
#pragma unroll 1
            for (int kk = 0; kk < 8; ++kk) {
                int lane_o = lane; asm volatile("" : "+v"(lane_o));
                const int r32 = lane_o & 31, hi = lane_o >> 5;
                const int rw = g == 2 ? 2 * kk + (wave >> 2) : (g == 0 ? 0 : (kk >> 1));
                const int iq0 = g == 2 ? 32 * (wave & 3) : (g == 0 ? 256 * kk : 256 * (kk & 1)) + 32 * wave;
                const size_t qrow = rowbase + (size_t)(iq0 + r32) * dil + rw;
                v4u rv[6]; AT_ISSUE(rv, kk, vkey, vcoff);
                bf16x8 qf[4];
#pragma unroll
                for (int d0 = 0; d0 < 4; ++d0) qf[d0] = *(const bf16x8*)(hb + qrow * 3072 + 16 * d0 + 8 * hi);
                asm volatile("" ::: "memory");
                const LAS float* bs = (const LAS float*)(lds + AT_BIAS);
                f32x16 pt[5];
#pragma unroll
                for (int kt = 0; kt < 5; ++kt) {
                    const bool valid = iq0 - 128 + 32 * kt >= 0;
                    if (valid) {
#pragma unroll
                        for (int r = 0; r < 16; ++r) pt[kt][r] = bs[(r32 - 4 * hi + 4) + (128 - 32 * kt - ((r & 3) + 8 * (r >> 2)) + 28)];
                        const LAS unsigned char* kb = lds + AT_K + (wave + kt) * 4096 + r32 * 128;
#pragma unroll
                        for (int d0 = 0; d0 < 4; ++d0) { const bf16x8 kf = *(const LAS bf16x8*)(kb + (((2 * d0 + hi) ^ (r32 & 7)) * 16)); pt[kt] = __builtin_amdgcn_mfma_f32_32x32x16_bf16(kf, qf[d0], pt[kt], 0, 0, 0); }
                        if (kt == 0) {
#pragma unroll
                            for (int r = 0; r < 16; ++r) if (((r & 3) + 8 * (r >> 2) + 4 * hi) < r32) pt[kt][r] = -INFINITY; }
                        if (kt == 4) {
#pragma unroll
                            for (int r = 0; r < 16; ++r) if (((r & 3) + 8 * (r >> 2) + 4 * hi) > r32) pt[kt][r] = -INFINITY; }
                    } else {
#pragma unroll
                        for (int r = 0; r < 16; ++r) pt[kt][r] = -INFINITY;
                    }
                }
                float mx = -INFINITY;
#pragma unroll
                for (int kt = 0; kt < 5; ++kt)
#pragma unroll
                    for (int r = 0; r < 16; ++r) mx = fmaxf(mx, pt[kt][r]);
                mx = fmaxf(mx, __shfl_xor(mx, 32));
                float lsum = 0.f;
#pragma unroll
                for (int kt = 0; kt < 5; ++kt)
#pragma unroll
                    for (int r = 0; r < 16; ++r) { pt[kt][r] = __builtin_amdgcn_exp2f(pt[kt][r] - mx); lsum += pt[kt][r]; }
                lsum += __shfl_xor(lsum, 32);
                bf16x8 pa[5][2];
#pragma unroll
                for (int kt = 0; kt < 5; ++kt)
#pragma unroll
                    for (int s = 0; s < 2; ++s) { v4u w; w.x = pg8::cvt_pk_bf16(pt[kt][8 * s + 0], pt[kt][8 * s + 1]); w.y = pg8::cvt_pk_bf16(pt[kt][8 * s + 2], pt[kt][8 * s + 3]); w.z = pg8::cvt_pk_bf16(pt[kt][8 * s + 4], pt[kt][8 * s + 5]); w.w = pg8::cvt_pk_bf16(pt[kt][8 * s + 6], pt[kt][8 * s + 7]); pa[kt][s] = __builtin_bit_cast(bf16x8, w); }
                AT_WRITE(rv, kk, AT_V, vdst);
                __syncthreads();
                v4u rk[6]; if (kk + 1 < 8) AT_ISSUE(rk, kk + 1, kkey, kcoff);
                asm volatile("" ::: "memory");
                f32x16 o[2];
#pragma unroll
                for (int r = 0; r < 16; ++r) { o[0][r] = 0.f; o[1][r] = 0.f; }
                const unsigned vb = (unsigned)(uintptr_t)(lds + AT_V) + ((lane_o >> 4) & 1) * 32 + (lane_o & 3) * 8 + (4 * hi + ((lane_o & 15) >> 2)) * 64;
#pragma unroll
                for (int kt = 0; kt < 5; ++kt) {
                    const bool valid = iq0 - 128 + 32 * kt >= 0;
                    if (valid) {
                        const unsigned va = vb + (wave + kt) * 4096; s16x4 lo[4], hv[4];
                        asm volatile("ds_read_b64_tr_b16 %0, %1" : "=v"(lo[0]) : "v"(va) : "memory");               asm volatile("ds_read_b64_tr_b16 %0, %1 offset:512" : "=v"(hv[0]) : "v"(va) : "memory");
                        asm volatile("ds_read_b64_tr_b16 %0, %1 offset:2048" : "=v"(lo[1]) : "v"(va) : "memory");   asm volatile("ds_read_b64_tr_b16 %0, %1 offset:2560" : "=v"(hv[1]) : "v"(va) : "memory");
                        asm volatile("ds_read_b64_tr_b16 %0, %1 offset:1024" : "=v"(lo[2]) : "v"(va) : "memory");   asm volatile("ds_read_b64_tr_b16 %0, %1 offset:1536" : "=v"(hv[2]) : "v"(va) : "memory");
                        asm volatile("ds_read_b64_tr_b16 %0, %1 offset:3072" : "=v"(lo[3]) : "v"(va) : "memory");   asm volatile("ds_read_b64_tr_b16 %0, %1 offset:3584" : "=v"(hv[3]) : "v"(va) : "memory");
                        asm volatile("s_waitcnt lgkmcnt(0)" : "+v"(lo[0]), "+v"(hv[0]), "+v"(lo[1]), "+v"(hv[1]), "+v"(lo[2]), "+v"(hv[2]), "+v"(lo[3]), "+v"(hv[3]) :: "memory");
#pragma unroll
                        for (int s = 0; s < 2; ++s)
#pragma unroll
                            for (int dh = 0; dh < 2; ++dh) { const int q_ = 2 * s + dh; const bf16x8 vf = (bf16x8){lo[q_][0], lo[q_][1], lo[q_][2], lo[q_][3], hv[q_][0], hv[q_][1], hv[q_][2], hv[q_][3]};
                                o[dh] = __builtin_amdgcn_mfma_f32_32x32x16_bf16(pa[kt][s], vf, o[dh], 0, 0, 0); }
                    }
                }
                LAS float* wsf = (LAS float*)(lds + AT_WSF) + wave * 64;
                if (hi == 0) { wsf[r32] = 1.0f / lsum; wsf[32 + r32] = mx + __builtin_amdgcn_logf(lsum); }
                LDS_WAIT(); asm volatile("" ::: "memory");
                LAS unsigned short* stg = (LAS unsigned short*)(lds + AT_OST + wave * 4096);
#pragma unroll
                for (int r = 0; r < 16; ++r) { const int orow = (r & 3) + 8 * (r >> 2) + 4 * hi; const float rl = wsf[orow];
                    const unsigned w2 = pg8::cvt_pk_bf16(o[0][r] * rl, o[1][r] * rl); stg[orow * 64 + r32] = (unsigned short)w2; stg[orow * 64 + 32 + r32] = (unsigned short)(w2 >> 16); }
                LDS_WAIT(); asm volatile("" ::: "memory");
#pragma unroll
                for (int i = 0; i < 4; ++i) { const int row = i * 8 + (lane_o >> 3), ch = lane_o & 7; v4u v = *(const LAS v4u*)(stg + row * 64 + ch * 8);
                    const size_t orow = rowbase + (size_t)(iq0 + row) * dil + rw;
                    bf16* dst = XN2 + orow * D + h * 64 + ch * 8;
                    if (g > 0) {
                        const float la = LSEACC[orow * 16 + h], lb = wsf[32 + row]; const float mm = fmaxf(la, lb);
                        float wa_ = __builtin_amdgcn_exp2f(la - mm), wb_ = __builtin_amdgcn_exp2f(lb - mm); const float inv = 1.0f / (wa_ + wb_); wa_ *= inv; wb_ *= inv;
                        const v4u pv = *(const v4u*)dst; v4u gt = (v4u){0x3f803f80u, 0x3f803f80u, 0x3f803f80u, 0x3f803f80u};
                        if (g == 2) gt = *(const v4u*)(GATE + orow * D + h * 64 + ch * 8);
#pragma unroll
                        for (int e = 0; e < 4; ++e) { const float a0 = __uint_as_float(pv[e] << 16), a1 = __uint_as_float(pv[e] & 0xffff0000u), b0 = __uint_as_float(v[e] << 16), b1 = __uint_as_float(v[e] & 0xffff0000u);
                            const float g0 = __uint_as_float(gt[e] << 16), g1 = __uint_as_float(gt[e] & 0xffff0000u);
                            v[e] = pg8::cvt_pk_bf16((wa_ * a0 + wb_ * b0) * g0, (wa_ * a1 + wb_ * b1) * g1); }
                        if (g == 1 && ch == 0) LSEACC[orow * 16 + h] = mm + __builtin_amdgcn_logf((__builtin_amdgcn_exp2f(la - mm) + __builtin_amdgcn_exp2f(lb - mm)));
                    } else if (ch == 0) LSEACC[orow * 16 + h] = wsf[32 + row];
                    *(v4u*)dst = v; }
                if (kk + 1 < 8) AT_WRITE(rk, kk + 1, AT_K, kdst);
                __syncthreads();
            }
#undef AT_SLOT
#undef AT_ISSUE
#undef AT_WRITE
}

struct Args { const float* in[14]; float* out; unsigned char* ws; int ph_lo, ph_hi, li, pad; };
constexpr int N_PHASES = 16;
#ifndef MK_NOSTORE_REP
#define MK_NOSTORE_REP 0
#endif
#ifndef MK_REP
#define MK_REP {1,1,1,1,1,1,1,1,1,1,1,1,1,1,1,1}
#endif
__device__ const int kRep[N_PHASES] = MK_REP;
#ifndef MK_N_LAUNCHES
#define MK_N_LAUNCHES 1
#endif
constexpr int N_LAUNCHES = MK_N_LAUNCHES;

__global__ void __launch_bounds__(NWAVES * 64, 2) mk_fwd(Args args) {
    extern __shared__ __attribute__((aligned(16))) unsigned char lds_raw[];
    LAS unsigned char* lds = (LAS unsigned char*)lds_raw;
    volatile LAS unsigned* MISC = (volatile LAS unsigned*)(lds + MISC_OFF);
    const int G = gridDim.x; const int bx = blockIdx.x; const int vcu0 = (G % 8 == 0) ? (bx % 8) * (G / 8) + bx / 8 : bx;
    const int NGW = G * NWAVES;
#define KA_LOAD() \
    int tid = threadIdx.x; asm volatile("" : "+v"(tid)); const int lane = tid & 63, wave = __builtin_amdgcn_readfirstlane(tid >> 6); \
    int vcu = vcu0; asm volatile("" : "+s"(vcu)); const int gw = vcu * NWAVES + wave; (void)lane; (void)gw; \
    const __attribute__((address_space(4))) Args* ka_ = (const __attribute__((address_space(4))) Args*)__builtin_amdgcn_kernarg_segment_ptr(); asm volatile("" : "+s"(ka_)); \
    unsigned char* ws = as_global(ka_->ws); float* out = as_global(ka_->out); (void)ws; (void)out; \
    const float* x = as_global(ka_->in[0]); const float* cvec = as_global(ka_->in[1]); const float* ada_w = as_global(ka_->in[2]); const float* ada_b = as_global(ka_->in[3]); const float* norm_g = as_global(ka_->in[4]); \
    const float* gla_w_in = as_global(ka_->in[5]); const float* gla_w_alpha = as_global(ka_->in[6]); const float* gla_b_alpha = as_global(ka_->in[7]); const float* gla_norm_g = as_global(ka_->in[8]); \
    const float* gla_w_out = as_global(ka_->in[9]); const float* dsw_w_in = as_global(ka_->in[10]); const float* dsw_w_out = as_global(ka_->in[11]); const float* rel_bias = as_global(ka_->in[12]); const float* final_g = as_global(ka_->in[13]); \
    (void)x; (void)cvec; (void)ada_w; (void)ada_b; (void)norm_g; (void)gla_w_in; (void)gla_w_alpha; (void)gla_b_alpha; (void)gla_norm_g; (void)gla_w_out; (void)dsw_w_in; (void)dsw_w_out; (void)rel_bias; (void)final_g; \
    float* MOD = (float*)(ws + WS_MOD); float* BIAS = (float*)(ws + WS_BIAS); (void)MOD; (void)BIAS; \
    bf16* WT0 = (bf16*)(ws + WS_WT0); bf16* WT1 = (bf16*)(ws + WS_WT1); bf16* WTO0 = (bf16*)(ws + WS_WTO0); bf16* WTO1 = (bf16*)(ws + WS_WTO1); (void)WT0; (void)WT1; (void)WTO0; (void)WTO1; \
    bf16* XN = (bf16*)(ws + WS_XN); bf16* XN2 = (bf16*)(ws + WS_XN2); bf16* QKVR = (bf16*)(ws + WS_QKVR); (void)XN; (void)XN2; (void)QKVR; \
    float* SSQ = (float*)(ws + WS_SSQ); float* GLR = (float*)(ws + WS_GLR); (void)SSQ; (void)GLR; \
    bf16* QKV1 = (bf16*)(ws + WS_QKV1); bf16* GATE = (bf16*)(ws + WS_GATE); (void)QKV1; (void)GATE;
    gu32* ctl = (gu32*)(args.ws + WS_CTL);

    for (int u = threadIdx.x; u < (LDS_BYTES - LDSCTL_OFF) / 4; u += NWAVES * 64) ((LAS unsigned*)(lds + LDSCTL_OFF))[u] = 0u;
    __syncthreads();
    XcdBarrier bar; bar.bar = (unsigned*)(ctl + CW_BAR); bar.x = 0; bar.st = nullptr;
    if (N_LAUNCHES == 1) bar = xcd_barrier_post((unsigned*)(ctl + CW_BAR), MISC + 8);
#define GRID_BAR() do { if (N_LAUNCHES == 1) xcd_barrier(bar); } while (0)
    const int lo = args.ph_lo, hi = args.ph_hi;
#define IN(k) (lo <= (k) && (k) < hi)
#define BOTH(k) (IN(k) && IN((k) + 1))

    if (IN(0)) { for (int rep_ = 0; rep_ < kRep[0]; ++rep_) { KA_LOAD();
        {
            LAS float* scr = (LAS float*)(lds + RING_OFF + wave * 16384);
            for (int it = gw; it < 7680; it += NGW) {
                int r = it;
                if (r < 1024) { transpose_item(gla_w_in, GLA_IN, 0, D, WT0, 0, scr, r / 64, r % 64, lane); continue; } r -= 1024;
                if (r < 512) { transpose_item(gla_w_in, GLA_IN, 2064, D, WT0, 2048, scr, r / 32, r % 32, lane); continue; } r -= 512;
                if (r < 5120) { transpose_item(dsw_w_in, DSW_IN, 0, D, WT1, 0, scr, r / 320, r % 320, lane); continue; } r -= 5120;
                if (r < 512) { transpose_item(gla_w_out, D, 0, D, WTO0, 0, scr, r / 32, r % 32, lane); continue; } r -= 512;
                transpose_item(dsw_w_out, D, 0, D, WTO1, 0, scr, r / 32, r % 32, lane);
            }
        }
        __syncthreads();
        if (vcu < 96) {
            const int layer = vcu / 48, cb = vcu % 48, col = cb * 64 + lane;
            LAS float* sc = (LAS float*)lds;
            LAS float* red = (LAS float*)(lds + 65536);
            for (int i = 0; i < 32; ++i) { const int idx = i * 512 + tid, b = idx >> 10, k = idx & 1023; sc[k * 16 + b] = silu_f(cvec[idx]); }
            __syncthreads();
            float acc[16];
#pragma unroll
            for (int b = 0; b < 16; ++b) acc[b] = 0.f;
            const float* wp = ada_w + (size_t)layer * D * 3072 + (size_t)(wave * 128) * 3072 + col;
#pragma unroll 4
            for (int kk = 0; kk < 128; ++kk) { const float w = wp[(size_t)kk * 3072]; const LAS f32x4* s4 = (const LAS f32x4*)(sc + (wave * 128 + kk) * 16);
#pragma unroll
                for (int q = 0; q < 4; ++q) { const f32x4 s = s4[q]; acc[4 * q + 0] += s[0] * w; acc[4 * q + 1] += s[1] * w; acc[4 * q + 2] += s[2] * w; acc[4 * q + 3] += s[3] * w; } }
#pragma unroll
            for (int b = 0; b < 16; ++b) red[(wave * 16 + b) * 64 + lane] = acc[b];
            __syncthreads();
            for (int r = 0; r < 2; ++r) { const int idx = tid + r * 512, b = idx >> 6, cl = idx & 63; float s = 0.f;
#pragma unroll
                for (int w = 0; w < 8; ++w) s += red[(w * 16 + b) * 64 + cl];
                MOD[(size_t)(layer * 16 + b) * 3072 + cb * 64 + cl] = s + ada_b[layer * 3072 + cb * 64 + cl]; }
            __syncthreads();
        }
        if (vcu == G - 1) {
            for (int idx = tid; idx < 3 * 16 * 132; idx += NWAVES * 64) { const int g = idx / (16 * 132), h = (idx / 132) % 16, s = idx % 132; const int dil = g == 0 ? 1 : (g == 1 ? 4 : 16);
                BIAS[idx] = (s <= 128) ? rel_bias[t5_bucket(s * dil) * 16 + h] * LOG2E : 0.f; }
        }
        __syncthreads(); } if (BOTH(0)) GRID_BAR();
    }

#define PRENORM(Xsrc, layer, WITH_GLR) do { \
        LAS float* wlr = (LAS float*)lds; \
        if (WITH_GLR) { for (int idx = tid; idx < 16384; idx += NWAVES * 64) { const int k = idx >> 4, c = idx & 15; wlr[c * 1028 + k] = gla_w_in[(size_t)k * GLA_IN + 2048 + c]; } __syncthreads(); } \
        const int b_ = gw >> 7; const float* mod_ = MOD + (size_t)((layer) * 16 + b_) * 3072; const float* gv_ = norm_g + (layer) * D; \
        f32x4 gs[4], sh[4]; \
        _Pragma("unroll") for (int j = 0; j < 4; ++j) { const int col = 256 * j + 4 * lane; const f32x4 g4 = *(const f32x4*)(gv_ + col), sc4 = *(const f32x4*)(mod_ + 1024 + col); sh[j] = *(const f32x4*)(mod_ + col); gs[j] = g4 * (1.f + sc4); } \
        for (int r = 0; r < 16; ++r) { asm volatile("" ::: "memory"); const size_t row = (size_t)gw * 16 + r; const float* xr = (Xsrc) + row * D; \
            f32x4 v[4]; float ss = 0.f; \
            _Pragma("unroll") for (int j = 0; j < 4; ++j) { v[j] = *(const f32x4*)(xr + 256 * j + 4 * lane); ss += (v[j][0] * v[j][0] + v[j][1] * v[j][1]) + (v[j][2] * v[j][2] + v[j][3] * v[j][3]); } \
            const float rstd = 1.0f / sqrtf(wave_sum(ss) * (1.f / D) + EPS); \
            _Pragma("unroll") for (int j = 0; j < 4; ++j) { v[j] = v[j] * rstd * gs[j] + sh[j]; \
                *(unsigned long long*)(XN + row * D + 256 * j + 4 * lane) = (unsigned long long)pk2(v[j][0], v[j][1]) | ((unsigned long long)pk2(v[j][2], v[j][3]) << 32); } \
            if (WITH_GLR) { float acc[16]; \
                _Pragma("unroll") for (int c = 0; c < 16; ++c) { float a = 0.f; \
                    _Pragma("unroll") for (int j = 0; j < 4; ++j) { const f32x4 w4 = *(const LAS f32x4*)(wlr + c * 1028 + 256 * j + 4 * lane); a += (v[j][0] * w4[0] + v[j][1] * w4[1]) + (v[j][2] * w4[2] + v[j][3] * w4[3]); } \
                    acc[c] = a; } \
                int col_; const float sres = reduce16(acc, lane, col_); if ((lane & 3) == 0) GLR[row * 16 + col_] = sres; } \
        } } while (0)

    if (IN(1)) { for (int rep_ = 0; rep_ < kRep[1]; ++rep_) { KA_LOAD(); PRENORM(x, 0, true); __syncthreads(); } if (BOTH(1)) GRID_BAR(); }

    if (IN(2)) { for (int rep_ = 0; rep_ < kRep[2]; ++rep_) { KA_LOAD();
        pg8::Gemm g{XN, WT0, M, N0, D}; pg8::StaticOrder S; S.init(M, N0, G, bx);
        pg8::EpiBf16S E{QKVR, N0, 2, QSCALE0};
        pg8::gemm_phase<pg8::EpiBf16S, pg8::StaticOrder, true, true>(lds + RING_OFF, g, S, E);
        __syncthreads(); } if (BOTH(2)) GRID_BAR();
    }

    if (IN(3)) { for (int rep_ = 0; rep_ < kRep[3]; ++rep_) { KA_LOAD();
        bf16* AM = (bf16*)(ws + WS_AM); bf16* QS = (bf16*)(ws + WS_QS); bf16* KST = (bf16*)(ws + WS_KST); float* DEC = (float*)(ws + WS_DEC);
        LAS unsigned short* qt = (LAS unsigned short*)lds;
        LAS unsigned short* kt = qt + 64 * 136;
        LAS float* tot = (LAS float*)(lds + 2 * 64 * 272);
        LAS float* fst = tot + 512;
        const int d = tid & 127, seg = tid >> 7, fr = lane & 15, kq = lane >> 4;
        const int bh = (vcu * 8) >> 5, h = bh & 3, b = bh >> 2;
        float wa[16];
#pragma unroll
        for (int i = 0; i < 16; ++i) wa[i] = gla_w_alpha[i * 512 + h * 128 + d];
        const float ba = gla_b_alpha[h * 128 + d];
        for (int it = 0; it < 8; ++it) {
            const int item = vcu * 8 + it, n = item & 31;
            const size_t row0 = (size_t)b * SEQ + n * 64;
            float bc[16]; float run = 0.f;
#pragma unroll
            for (int u = 0; u < 16; ++u) { const float* gl = GLR + (row0 + 16 * seg + u) * 16; float z = ba;
#pragma unroll
                for (int q4 = 0; q4 < 4; ++q4) { const f32x4 g4 = *(const f32x4*)(gl + 4 * q4); z += g4[0] * wa[4 * q4] + g4[1] * wa[4 * q4 + 1] + g4[2] * wa[4 * q4 + 2] + g4[3] * wa[4 * q4 + 3]; }
                const float ls = fminf(z, 0.f) - __logf(1.f + __expf(-fabsf(z)));
                run += ls * (1.f / 16.f); bc[u] = run; }
            tot[seg * 128 + d] = run; fst[seg * 128 + d] = bc[0];
            __syncthreads();
            const float t0 = tot[d], t1 = tot[128 + d], t2 = tot[256 + d], t3 = tot[384 + d];
            const float off = (seg > 0 ? t0 : 0.f) + (seg > 1 ? t1 : 0.f) + (seg > 2 ? t2 : 0.f);
            const float blast = (t0 + t1) + (t2 + t3), mid = (t0 + t1) + fst[256 + d];
            unsigned short ksv[16];
#pragma unroll
            for (int u = 0; u < 16; ++u) { const int t = 16 * seg + u; const float bb = bc[u] + off;
                const float q = bf2f(QKVR[(row0 + t) * N0 + h * 128 + d]), k = bf2f(QKVR[(row0 + t) * N0 + 512 + h * 128 + d]);
                const float e1 = __expf(bb - mid), e2 = __expf(mid - bb);
                qt[t * 136 + d] = (unsigned short)f2bf(q * e1); kt[t * 136 + d] = (unsigned short)f2bf(k * e2);
                const int d32 = d & 31;
                QS[(row0 + t) * 512 + h * 128 + (d & ~31) + 8 * ((d32 & 15) >> 2) + (d32 & 3) + 4 * (d32 >> 4)] = (bf16)f2bf(q * __expf(bb));
                ksv[u] = (unsigned short)f2bf(k * __expf(blast - bb)); }
#pragma unroll
            for (int gq = 0; gq < 4; ++gq)
                *(unsigned long long*)(KST + ((size_t)item * 128 + d) * 64 + 32 * (seg >> 1) + 8 * gq + 4 * (seg & 1)) =
                    (unsigned long long)ksv[4 * gq] | ((unsigned long long)ksv[4 * gq + 1] << 16) | ((unsigned long long)ksv[4 * gq + 2] << 32) | ((unsigned long long)ksv[4 * gq + 3] << 48);
            if (seg == 0) DEC[(size_t)item * 128 + d] = __expf(blast);
            __syncthreads();
            { const int ti = wave >> 1;
#pragma unroll
              for (int jj = 0; jj < 2; ++jj) { const int tj = 2 * (wave & 1) + jj; f32x4 acc = (f32x4){0.f, 0.f, 0.f, 0.f};
                if (tj <= ti) {
#pragma unroll
                    for (int ks = 0; ks < 4; ++ks) { const bf16x8 af = *(const LAS bf16x8*)(kt + (16 * tj + fr) * 136 + 32 * ks + 8 * kq), bfv = *(const LAS bf16x8*)(qt + (16 * ti + fr) * 136 + 32 * ks + 8 * kq);
                        acc = __builtin_amdgcn_mfma_f32_16x16x32_bf16(af, bfv, acc, 0, 0, 0); } }
                const int i = 16 * ti + fr, j0 = 16 * tj + 4 * kq;
                unsigned short w4[4];
#pragma unroll
                for (int r = 0; r < 4; ++r) w4[r] = (j0 + r <= i) ? (unsigned short)f2bf(acc[r]) : (unsigned short)0;
                *(unsigned long long*)(AM + ((size_t)item * 64 + i) * 64 + 32 * (tj >> 1) + 8 * kq + 4 * (tj & 1)) =
                    (unsigned long long)w4[0] | ((unsigned long long)w4[1] << 16) | ((unsigned long long)w4[2] << 32) | ((unsigned long long)w4[3] << 48); } }
        }
        __syncthreads(); } if (BOTH(3)) GRID_BAR();
    }

    if (IN(4)) { for (int rep_ = 0; rep_ < kRep[4]; ++rep_) { KA_LOAD();
        const bf16* AM = (const bf16*)(ws + WS_AM); const bf16* QS = (const bf16*)(ws + WS_QS); const bf16* KST = (const bf16*)(ws + WS_KST); const float* DEC = (const float*)(ws + WS_DEC);
        bf16* O = XN;
        constexpr int SC_AM = 0, SC_QS = 9216, SC_KS = 9216 + 17408, SC_V = SC_KS + 18432, SC_DC = SC_V + 9216, SC_BUF = SC_DC + 512;
        const int item = vcu, b = item >> 4, h = (item >> 2) & 3, dvs = item & 3, bh = b * 4 + h;
        const int fr = lane & 15, kq = lane >> 4;
#define SCAN_LOAD(n_, t0_, NT_) do { const int n__ = (n_); LAS unsigned char* B_ = lds + (n__ & 1) * SC_BUF; const size_t ci_ = (size_t)bh * 32 + n__, r0_ = (size_t)b * SEQ + n__ * 64; \
            for (int pid = tid - (t0_); pid < 512; pid += (NT_)) { const int r_ = pid >> 3, c_ = pid & 7; \
                *(LAS v4u*)(B_ + SC_AM + r_ * 144 + c_ * 16) = *(const v4u*)(AM + (ci_ * 64 + r_) * 64 + c_ * 8); \
                *(LAS v4u*)(B_ + SC_V + r_ * 144 + c_ * 16) = *(const v4u*)(QKVR + (r0_ + r_) * N0 + 1024 + h * 256 + dvs * 64 + c_ * 8); } \
            for (int pid = tid - (t0_); pid < 1024; pid += (NT_)) { const int r_ = pid >> 4, c_ = pid & 15; \
                *(LAS v4u*)(B_ + SC_QS + r_ * 272 + c_ * 16) = *(const v4u*)(QS + (r0_ + r_) * 512 + h * 128 + c_ * 8); } \
            for (int pid = tid - (t0_); pid < 1024; pid += (NT_)) { const int r_ = pid >> 3, c_ = pid & 7; \
                *(LAS v4u*)(B_ + SC_KS + r_ * 144 + c_ * 16) = *(const v4u*)(KST + (ci_ * 128 + r_) * 64 + c_ * 8); } \
            if (tid - (t0_) < 32) *(LAS v4u*)(B_ + SC_DC + (tid - (t0_)) * 16) = *(const v4u*)(DEC + ci_ * 128 + (tid - (t0_)) * 4); } while (0)
        v4u hrA[6], hrB[6]; v4u hdcA, hdcB;
#define SCAN_ISSUE(n_, hr, hdc) do { const int n__ = (n_); const size_t ci_ = (size_t)bh * 32 + n__, r0_ = (size_t)b * SEQ + n__ * 64; \
            hr[0] = *(const v4u*)(AM + (ci_ * 64 + (tid >> 3)) * 64 + (tid & 7) * 8); hr[1] = *(const v4u*)(QKVR + (r0_ + (tid >> 3)) * N0 + 1024 + h * 256 + dvs * 64 + (tid & 7) * 8); \
            _Pragma("unroll") for (int i_ = 0; i_ < 2; ++i_) { const int pid = tid + 512 * i_; \
                hr[2 + i_] = *(const v4u*)(QS + (r0_ + (pid >> 4)) * 512 + h * 128 + (pid & 15) * 8); hr[4 + i_] = *(const v4u*)(KST + (ci_ * 128 + (pid >> 3)) * 64 + (pid & 7) * 8); } \
            if (tid < 32) hdc = *(const v4u*)(DEC + ci_ * 128 + tid * 4); } while (0)
#define SCAN_WRITE(n_, hr, hdc) do { LAS unsigned char* B_ = lds + ((n_) & 1) * SC_BUF; \
            *(LAS v4u*)(B_ + SC_AM + (tid >> 3) * 144 + (tid & 7) * 16) = hr[0]; *(LAS v4u*)(B_ + SC_V + (tid >> 3) * 144 + (tid & 7) * 16) = hr[1]; \
            _Pragma("unroll") for (int i_ = 0; i_ < 2; ++i_) { const int pid = tid + 512 * i_; \
                *(LAS v4u*)(B_ + SC_QS + (pid >> 4) * 272 + (pid & 15) * 16) = hr[2 + i_]; *(LAS v4u*)(B_ + SC_KS + (pid >> 3) * 144 + (pid & 7) * 16) = hr[4 + i_]; } \
            if (tid < 32) *(LAS v4u*)(B_ + SC_DC + tid * 16) = hdc; } while (0)
        SCAN_LOAD(0, 0, 512);
        SCAN_ISSUE(1, hrB, hdcB); SCAN_ISSUE(2, hrA, hdcA);
        __syncthreads();
        f32x4 S[8];
#pragma unroll
        for (int T = 0; T < 8; ++T) S[T] = (f32x4){0.f, 0.f, 0.f, 0.f};
#define SCAN_COMPUTE(n_) do { const int nn_ = (n_); \
                const LAS unsigned char* B_ = lds + (nn_ & 1) * SC_BUF; const size_t row0 = (size_t)b * SEQ + nn_ * 64; \
                bf16x8 vf[2]; \
                _Pragma("unroll") \
                for (int ks = 0; ks < 2; ++ks) { const LAS unsigned char* vp = B_ + SC_V + (32 * ks + 4 * kq + (fr >> 2)) * 144 + (16 * wave + 4 * (fr & 3)) * 2; \
                    s16x4 lo, hi; \
                    asm volatile("ds_read_b64_tr_b16 %0, %1" : "=v"(lo) : "v"((unsigned)(uintptr_t)vp) : "memory"); \
                    asm volatile("ds_read_b64_tr_b16 %0, %1 offset:2304" : "=v"(hi) : "v"((unsigned)(uintptr_t)vp) : "memory"); \
                    asm volatile("s_waitcnt lgkmcnt(0)" : "+v"(lo), "+v"(hi) :: "memory"); \
                    vf[ks] = (bf16x8){lo[0], lo[1], lo[2], lo[3], hi[0], hi[1], hi[2], hi[3]}; } \
                bf16x8 sb[4]; \
                _Pragma("unroll") \
                for (int kd = 0; kd < 4; ++kd) { const f32x4 s0 = S[2 * kd], s1 = S[2 * kd + 1]; v4u w; w.x = pk2(s0[0], s0[1]); w.y = pk2(s0[2], s0[3]); w.z = pk2(s1[0], s1[1]); w.w = pk2(s1[2], s1[3]); sb[kd] = __builtin_bit_cast(bf16x8, w); } \
                _Pragma("unroll") \
                for (int tb = 0; tb < 4; ++tb) { f32x4 acc = (f32x4){0.f, 0.f, 0.f, 0.f}; \
                _Pragma("unroll") \
                    for (int ks = 0; ks < 2; ++ks) if (ks <= (tb >> 1)) { const bf16x8 af = *(const LAS bf16x8*)(B_ + SC_AM + (16 * tb + fr) * 144 + (32 * ks + 8 * kq) * 2); acc = __builtin_amdgcn_mfma_f32_16x16x32_bf16(af, vf[ks], acc, 0, 0, 0); } \
                _Pragma("unroll") \
                    for (int kd = 0; kd < 4; ++kd) { const bf16x8 af = *(const LAS bf16x8*)(B_ + SC_QS + (16 * tb + fr) * 272 + (32 * kd + 8 * kq) * 2); acc = __builtin_amdgcn_mfma_f32_16x16x32_bf16(af, sb[kd], acc, 0, 0, 0); } \
                _Pragma("unroll") \
                    for (int r = 0; r < 4; ++r) { const size_t row = row0 + 16 * tb + 4 * kq + r; O[row * D + h * 256 + dvs * 64 + 16 * wave + fr] = (bf16)f2bf(acc[r]); \
                        const float ss = row16_sum(acc[r] * acc[r]); \
                        if (fr == 0) SSQ[row * 64 + h * 16 + dvs * 4 + wave] = ss; } } \
                _Pragma("unroll") \
                for (int T = 0; T < 8; ++T) { const f32x4 dc = *(const LAS f32x4*)(B_ + SC_DC + (16 * T + 4 * kq) * 4); S[T] = S[T] * dc; \
                _Pragma("unroll") \
                    for (int ks = 0; ks < 2; ++ks) { const bf16x8 af = *(const LAS bf16x8*)(B_ + SC_KS + (16 * T + fr) * 144 + (32 * ks + 8 * kq) * 2); S[T] = __builtin_amdgcn_mfma_f32_16x16x32_bf16(af, vf[ks], S[T], 0, 0, 0); } } \
            } while (0)
        for (int n = 0; n < 32; n += 2) {
            SCAN_WRITE(n + 1, hrB, hdcB); asm volatile("" ::: "memory"); if (n + 3 < 32) SCAN_ISSUE(n + 3, hrB, hdcB);
            if (wave < 4) SCAN_COMPUTE(n);
            __syncthreads();
            if (n + 2 < 32) SCAN_WRITE(n + 2, hrA, hdcA); asm volatile("" ::: "memory"); if (n + 4 < 32) SCAN_ISSUE(n + 4, hrA, hdcA);
            if (wave < 4) SCAN_COMPUTE(n + 1);
            __syncthreads();
        }
#undef SCAN_COMPUTE
#undef SCAN_LOAD
#undef SCAN_ISSUE
#undef SCAN_WRITE
        __syncthreads(); } if (BOTH(4)) GRID_BAR();
    }

    if (IN(5)) { for (int rep_ = 0; rep_ < kRep[5]; ++rep_) { KA_LOAD();
        const bf16* O = XN;
        const f32x4 g4 = *(const f32x4*)(gla_norm_g + 4 * lane);
        for (int r = 0; r < 16; ++r) { const size_t row = (size_t)gw * 16 + r;
#pragma unroll
            for (int j = 0; j < 4; ++j) { const int col = 256 * j + 4 * lane; float sum = 0.f;
#pragma unroll
                for (int q4 = 0; q4 < 4; ++q4) { const f32x4 s4 = *(const f32x4*)(SSQ + row * 64 + 16 * j + 4 * q4); sum += (s4[0] + s4[1]) + (s4[2] + s4[3]); }
                const float rstd = 1.0f / sqrtf(sum * (1.f / 256.f) + EPS);
                const unsigned long long ob = *(const unsigned long long*)(O + row * D + col), rb = *(const unsigned long long*)(QKVR + row * N0 + 2048 + col);
                float o[4], rr[4];
#pragma unroll
                for (int i = 0; i < 4; ++i) { o[i] = bf2f((bf16)(ob >> (16 * i))); rr[i] = bf2f((bf16)(rb >> (16 * i))); o[i] = o[i] * rstd * g4[i] * silu_f(rr[i]); }
                *(unsigned long long*)(XN2 + row * D + col) = (unsigned long long)pk2(o[0], o[1]) | ((unsigned long long)pk2(o[2], o[3]) << 32); } }
        __syncthreads(); } if (BOTH(5)) GRID_BAR();
    }

    if (IN(6)) { for (int rep_ = 0; rep_ < kRep[6]; ++rep_) { KA_LOAD();
        pg8::Gemm g{XN2, WTO0, M, D, D}; pg8::StaticOrder S; S.init(M, D, G, bx);
        pg8::EpiResid E{x, out, D, MOD + 2048};
        pg8::gemm_phase<pg8::EpiResid, pg8::StaticOrder, true, true>(lds + RING_OFF, g, S, E);
        __syncthreads(); } if (BOTH(6)) GRID_BAR();
    }

    if (IN(7)) { for (int rep_ = 0; rep_ < kRep[7]; ++rep_) { KA_LOAD(); PRENORM(out, 1, false); __syncthreads(); } if (BOTH(7)) GRID_BAR(); }

#define LAYER1_GROUP(g_) do { \
        if (IN(8 + 2 * (g_))) { for (int rep_ = 0; rep_ < kRep[8 + 2 * (g_)]; ++rep_) { KA_LOAD(); \
            constexpr int Ng = (g_) == 2 ? 4096 : 3072; \
            pg8::Gemm gm{XN, WT1 + (size_t)(g_) * 3072 * D, M, Ng, D}; pg8::StaticOrder S; S.init(M, Ng, G, bx); \
            pg8::EpiQkvGate E{QKV1, GATE, QSCALE1, MK_NOSTORE_REP ? (rep_ > 0) : 0}; \
            pg8::gemm_phase<pg8::EpiQkvGate, pg8::StaticOrder, true, true>(lds + RING_OFF, gm, S, E); \
            __syncthreads(); } if (BOTH(8 + 2 * (g_))) GRID_BAR(); } \
        if (IN(9 + 2 * (g_))) { for (int rep_ = 0; rep_ < kRep[9 + 2 * (g_)]; ++rep_) { KA_LOAD(); \
            attn_group<(g_)>(lds, QKV1, BIAS, XN2, GATE, (float*)(ws + WS_LSEACC), vcu, tid, lane, wave); \
            __syncthreads(); } if (BOTH(9 + 2 * (g_))) GRID_BAR(); } } while (0)
    LAYER1_GROUP(0); LAYER1_GROUP(1); LAYER1_GROUP(2);
#undef LAYER1_GROUP

    if (IN(14)) { for (int rep_ = 0; rep_ < kRep[14]; ++rep_) { KA_LOAD();
        pg8::Gemm g{XN2, WTO1, M, D, D}; pg8::StaticOrder S; S.init(M, D, G, bx);
        pg8::EpiResid E{out, out, D, MOD + (size_t)16 * 3072 + 2048};
        pg8::gemm_phase<pg8::EpiResid, pg8::StaticOrder, true, true>(lds + RING_OFF, g, S, E);
        __syncthreads(); } if (BOTH(14)) GRID_BAR();
    }

    if (IN(15)) { for (int rep_ = 0; rep_ < kRep[15]; ++rep_) { KA_LOAD();
        f32x4 fg[4];
#pragma unroll
        for (int j = 0; j < 4; ++j) fg[j] = *(const f32x4*)(final_g + 256 * j + 4 * lane);
        for (int r = 0; r < 16; ++r) { const size_t row = (size_t)gw * 16 + r; float* xr = out + row * D;
            f32x4 v[4]; float ss = 0.f;
#pragma unroll
            for (int j = 0; j < 4; ++j) { v[j] = *(const f32x4*)(xr + 256 * j + 4 * lane); ss += (v[j][0] * v[j][0] + v[j][1] * v[j][1]) + (v[j][2] * v[j][2] + v[j][3] * v[j][3]); }
            const float rstd = 1.0f / sqrtf(wave_sum(ss) * (1.f / D) + EPS);
#pragma unroll
            for (int j = 0; j < 4; ++j) *(f32x4*)(xr + 256 * j + 4 * lane) = v[j] * rstd * fg[j]; }
    } }
#ifdef MK_EXTRA_BARS
    for (int xb = 0; xb < MK_EXTRA_BARS; ++xb) GRID_BAR();
#endif
#undef IN
#undef BOTH
#undef GRID_BAR
#undef PRENORM
#undef KA_LOAD
}

extern "C" void kernel_launch(void* const* d_in, const int* in_sizes, int n_in, void* d_out, int out_size, void* d_ws, size_t ws_size, hipStream_t stream) {
    static int grid = 0;
    if (grid == 0) {
        if (n_in != 14 || in_sizes[0] != M * D || out_size != M * D || ws_size < WS_END) { fprintf(stderr, "kernel_launch: unexpected problem shape / workspace (n_in %d, in0 %d, out %d, ws %zu < %zu); nothing launched\n", n_in, n_in > 0 ? in_sizes[0] : -1, out_size, ws_size, (size_t)WS_END); grid = -1; return; }
        int dev = 0, cus = 0, per_cu = 0;
        if (hipGetDevice(&dev) != hipSuccess || hipDeviceGetAttribute(&cus, hipDeviceAttributeMultiprocessorCount, dev) != hipSuccess) { fprintf(stderr, "kernel_launch: device query failed\n"); grid = -1; return; }
        if (hipFuncSetAttribute((const void*)mk_fwd, hipFuncAttributeMaxDynamicSharedMemorySize, LDS_BYTES) != hipSuccess) { fprintf(stderr, "kernel_launch: hipFuncSetAttribute failed\n"); grid = -1; return; }
        if (hipOccupancyMaxActiveBlocksPerMultiprocessor(&per_cu, (const void*)mk_fwd, NWAVES * 64, LDS_BYTES) != hipSuccess || per_cu < 1)
            fprintf(stderr, "kernel_launch: note: occupancy query reports %d workgroups per CU\n", per_cu);
        (void)hipGetLastError();
        grid = cus;
        if (grid != 256) fprintf(stderr, "kernel_launch: note: %d CUs (tuned for 256)\n", grid);
    }
    if (grid < 0) return;
    if (hipMemsetAsync((char*)d_ws + WS_CTL, 0, CTL_ZERO_BYTES, stream) != hipSuccess) { fprintf(stderr, "kernel_launch: hipMemsetAsync failed\n"); return; }
    Args a{};
    for (int i = 0; i < 14; ++i) a.in[i] = (const float*)d_in[i];
    a.out = (float*)d_out; a.ws = (unsigned char*)d_ws;
    for (int li = 0; li < N_LAUNCHES; ++li) {
        a.ph_lo = (N_LAUNCHES == 1) ? 0 : li; a.ph_hi = (N_LAUNCHES == 1) ? N_PHASES : li + 1; a.li = li;
        hipLaunchKernelGGL(mk_fwd, dim3(grid), dim3(NWAVES * 64), LDS_BYTES, stream, a);
        const hipError_t le = hipPeekAtLastError();
        if (le != hipSuccess) { fprintf(stderr, "kernel_launch: launch %d failed: %s\n", li, hipGetErrorName(le)); break; }
    }
}
```
